# Optimizing an MI355X kernel written in HIP

```python
import math
import jax, jax.numpy as jnp
from jax import lax
import numpy as np

D_MODEL = 1024
BATCH = 4
SEQ = 8192
DEPTH = 1

CHUNK = 64
D_MIX = 1024
EPS = 1e-6
GMLP_GROUPS = 4
GMLP_GROUP_DIM = 128
GMLP_WIDTH = GMLP_GROUPS * GMLP_GROUP_DIM
GMLP_BLOCK = 128
DSA_HEADS = 8
DSA_V_DIM = 64
DSA_WIDTH = DSA_HEADS * DSA_V_DIM
DSA_NOPE_DIM = 64
DSA_ROPE_DIM = 32
DSA_Q_RANK = 256
DSA_KV_RANK = 128
IDX_HEADS = 8
IDX_DIM = 64
TOPK_MAX = 256
Q_BLOCK = 128
ROPE_THETA = 10000.0

IN_SIZES = (2 * GMLP_WIDTH, GMLP_WIDTH, DSA_Q_RANK, DSA_KV_RANK, DSA_ROPE_DIM, IDX_DIM, IDX_HEADS, DSA_WIDTH)
D_IN = sum(IN_SIZES)
IN_SPLITS = tuple(int(v) for v in np.cumsum(IN_SIZES)[:-1])

kernel_name = "hymba_gmlp_dsa_streaming_block"


def rmsnorm(x, g):
    x32 = x.astype(jnp.float32)
    r = x32 * lax.rsqrt(jnp.mean(x32 * x32, axis=-1, keepdims=True) + EPS)
    return (r * g.astype(jnp.float32)).astype(x.dtype)


def layernorm(x, g, b):
    x32 = x.astype(jnp.float32)
    mu = jnp.mean(x32, axis=-1, keepdims=True)
    var = jnp.mean(jnp.square(x32 - mu), axis=-1, keepdims=True)
    r = (x32 - mu) * lax.rsqrt(var + EPS)
    return (r * g.astype(jnp.float32) + b.astype(jnp.float32)).astype(x.dtype)


def rope_tables(seq_len):
    pos = jnp.arange(seq_len, dtype=jnp.float32)
    inv_freq = ROPE_THETA ** (-jnp.arange(0, DSA_ROPE_DIM, 2, dtype=jnp.float32) / DSA_ROPE_DIM)
    ang = pos[:, None] * inv_freq[None, :]
    return jnp.cos(ang), jnp.sin(ang)


def apply_rope(x, cos, sin):
    cos = cos.astype(x.dtype)
    sin = sin.astype(x.dtype)
    x1, x2 = jnp.split(x, 2, axis=-1)
    return jnp.concatenate([x1 * cos - x2 * sin, x2 * cos + x1 * sin], axis=-1)


def gmlp_branch(uv, z, ln_g, ln_b, w_s, b_s):
    B, S, _ = uv.shape
    uv = jax.nn.gelu(uv, approximate=False)
    u, v = jnp.split(uv, 2, axis=-1)
    v = layernorm(v, ln_g, ln_b)
    nb = S // GMLP_BLOCK
    v = v.reshape(B, nb, GMLP_BLOCK, GMLP_GROUPS, GMLP_GROUP_DIM)
    p = jnp.arange(GMLP_BLOCK)
    mask = (p[None, :] // CHUNK) <= (p[:, None] // CHUNK)
    w = jnp.where(mask[None], w_s, 0.0).astype(v.dtype)
    y = jnp.einsum('gts,bnsgc->bntgc', w, v) + b_s.T.astype(v.dtype)[None, None, :, :, None]
    y = y.reshape(B, S, GMLP_WIDTH)
    return u * y * jax.nn.silu(z)


def dsa_branch(c_q, c_kv, k_rope, k_idx, w_idx, z, q_norm_g, kv_norm_g, w_uq, w_uk, w_uv, w_q_idx):
    B, S, _ = c_q.shape
    cos, sin = rope_tables(S)
    c_q = rmsnorm(c_q, q_norm_g)
    c_kv = rmsnorm(c_kv, kv_norm_g)
    q = (c_q @ w_uq).reshape(B, S, DSA_HEADS, DSA_NOPE_DIM + DSA_ROPE_DIM)
    q_nope, q_rope = q[..., :DSA_NOPE_DIM], q[..., DSA_NOPE_DIM:]
    q_rope = apply_rope(q_rope, cos[:, None, :], sin[:, None, :])
    k_rope = apply_rope(k_rope, cos, sin)
    q_lat = jnp.einsum('bshd,chd->bshc', q_nope, w_uk)
    q_idx = (c_q @ w_q_idx).reshape(B, S, IDX_HEADS, IDX_DIM)
    w_idx = w_idx * (IDX_HEADS ** -0.5 * IDX_DIM ** -0.5)
    top_k = min(TOPK_MAX, S // 4)
    scale = 1.0 / math.sqrt(DSA_NOPE_DIM + DSA_ROPE_DIM)
    nqb = S // Q_BLOCK
    key_chunk = jnp.arange(S) // CHUNK
    b_ix = jnp.arange(B)[:, None, None]

    def to_blocks(a):
        return a.reshape((B, nqb, Q_BLOCK) + a.shape[2:]).swapaxes(0, 1)

    def block(args):
        ql, qr, qi, wi, nblk = args
        t = nblk * Q_BLOCK + jnp.arange(Q_BLOCK)
        logits = jnp.einsum('bqhd,bsd->bqhs', qi, k_idx)
        score = jnp.einsum('bqh,bqhs->bqs', wi, jax.nn.relu(logits)).astype(jnp.float32)
        admissible = key_chunk[None, :] <= (t // CHUNK)[:, None]
        score = jnp.where(admissible[None], score, -jnp.inf)
        top_val, top_idx = lax.top_k(score, top_k)
        valid = jnp.isfinite(top_val)
        c_sel = c_kv[b_ix, top_idx]
        kr_sel = k_rope[b_ix, top_idx]
        s = (jnp.einsum('bqhc,bqkc->bqhk', ql, c_sel)
             + jnp.einsum('bqhr,bqkr->bqhk', qr, kr_sel)).astype(jnp.float32) * scale
        s = jnp.where(valid[:, :, None, :], s, -jnp.inf)
        p = jax.nn.softmax(s, axis=-1).astype(c_sel.dtype)
        return jnp.einsum('bqhk,bqkc->bqhc', p, c_sel)

    xs = (to_blocks(q_lat), to_blocks(q_rope), to_blocks(q_idx), to_blocks(w_idx), jnp.arange(nqb))
    o_lat = lax.map(block, xs)
    o_lat = o_lat.swapaxes(0, 1).reshape(B, S, DSA_HEADS, DSA_KV_RANK)
    o = jnp.einsum('bshc,chd->bshd', o_lat, w_uv).reshape(B, S, DSA_WIDTH)
    return o * jax.nn.silu(z)


def setup_inputs(seed: int = 0) -> dict:
    key = jax.random.key(seed)
    ks = jax.random.split(key, 16)
    f32 = jnp.float32
    nrm = lambda k, shape, s: jax.random.normal(k, shape, f32) * s
    return {
        "x": jax.random.normal(ks[0], (BATCH, SEQ, D_MODEL), f32),
        "w_in": nrm(ks[1], (DEPTH, D_MODEL, D_IN), D_MODEL ** -0.5),
        "pre_norm_g": 1.0 + nrm(ks[2], (DEPTH, D_MODEL), 0.02),
        "post_norm_g": 1.0 + nrm(ks[3], (DEPTH, D_MODEL), 0.02),
        "gmlp_ln_g": 1.0 + nrm(ks[4], (DEPTH, GMLP_WIDTH), 0.02),
        "gmlp_ln_b": nrm(ks[5], (DEPTH, GMLP_WIDTH), 0.02),
        "gmlp_w_s": nrm(ks[6], (DEPTH, GMLP_GROUPS, GMLP_BLOCK, GMLP_BLOCK), GMLP_BLOCK ** -0.5),
        "gmlp_b_s": 1.0 + nrm(ks[7], (DEPTH, GMLP_GROUPS, GMLP_BLOCK), 0.1),
        "dsa_q_norm_g": 1.0 + nrm(ks[8], (DEPTH, DSA_Q_RANK), 0.02),
        "dsa_kv_norm_g": 1.0 + nrm(ks[9], (DEPTH, DSA_KV_RANK), 0.02),
        "dsa_w_uq": nrm(ks[10], (DEPTH, DSA_Q_RANK, DSA_HEADS * (DSA_NOPE_DIM + DSA_ROPE_DIM)), DSA_Q_RANK ** -0.5),
        "dsa_w_uk": nrm(ks[11], (DEPTH, DSA_KV_RANK, DSA_HEADS, DSA_NOPE_DIM), DSA_NOPE_DIM ** -0.5),
        "dsa_w_uv": nrm(ks[12], (DEPTH, DSA_KV_RANK, DSA_HEADS, DSA_V_DIM), DSA_KV_RANK ** -0.5),
        "dsa_w_q_idx": nrm(ks[13], (DEPTH, DSA_Q_RANK, IDX_HEADS * IDX_DIM), DSA_Q_RANK ** -0.5),
        "w_out": nrm(ks[14], (DEPTH, D_MIX, D_MODEL), D_MIX ** -0.5),
    }


def reference(x, w_in, pre_norm_g, post_norm_g, gmlp_ln_g, gmlp_ln_b, gmlp_w_s, gmlp_b_s,
              dsa_q_norm_g, dsa_kv_norm_g, dsa_w_uq, dsa_w_uk, dsa_w_uv, dsa_w_q_idx, w_out):
    for l in range(DEPTH):
        h = rmsnorm(x, pre_norm_g[l])
        proj = h @ w_in[l]
        uv_a, z_a, c_q, c_kv, k_rope, k_idx, w_idx, z_b = jnp.split(proj, IN_SPLITS, axis=-1)
        out_a = gmlp_branch(uv_a, z_a, gmlp_ln_g[l], gmlp_ln_b[l], gmlp_w_s[l], gmlp_b_s[l])
        out_b = dsa_branch(c_q, c_kv, k_rope, k_idx, w_idx, z_b, dsa_q_norm_g[l], dsa_kv_norm_g[l],
                           dsa_w_uq[l], dsa_w_uk[l], dsa_w_uv[l], dsa_w_q_idx[l])
        y = jnp.concatenate([out_a, out_b], axis=-1) @ w_out[l]
        x = x + rmsnorm(y, post_norm_g[l])
    return x
```

```cpp
#include <hip/hip_runtime.h>
#include <cstdio>
#include <cstdint>

typedef _Float16 h16;
typedef _Float16 h16x8 __attribute__((ext_vector_type(8)));
typedef _Float16 h16x4 __attribute__((ext_vector_type(4)));
typedef float f32x4 __attribute__((ext_vector_type(4)));

constexpr int BATCH = 4, SEQ = 8192, T = BATCH * SEQ, DM = 1024;
constexpr int NIN = 2536, NP = 2560;
constexpr int GW = 512;
constexpr int QR = 256, CKV = 128, ROPE = 32, IDXD = 64, NH = 8;
constexpr int KVD = CKV + ROPE;
constexpr int N2 = 1792;
constexpr int TOPK = 256;
constexpr float EPS = 1e-6f;
constexpr int C_U = 0, C_V = 512, C_ZA = 1024, C_ZB = 1536, C_CQ = 2048, C_CKV = 2304, C_KR = 2432, C_KI = 2464, C_WI = 2528;
__host__ __device__ inline int old_col(int n) {
    if (n < 1536) return n;
    if (n < 2048) return 2024 + (n - 1536);
    if (n < 2304) return 1536 + (n - 2048);
    if (n < 2432) return 1792 + (n - 2304);
    if (n < 2464) return 1920 + (n - 2432);
    if (n < 2528) return 1952 + (n - 2464);
    if (n < 2536) return 2016 + (n - 2528);
    return -1;
}

constexpr size_t MiB = 1u << 20;
constexpr size_t WS_CTL = 0;
constexpr size_t WS_SSQ = 64 * 1024;
constexpr size_t WS_SSKV = WS_SSQ + T * 4;
constexpr size_t WS_SSY = WS_SSKV + T * 4;
constexpr size_t WS_KMAX = WS_SSY + T * 4;
constexpr size_t WS_WINT = 1 * MiB;
constexpr size_t WS_W2T = 6 * MiB;
constexpr size_t WS_WOUTT = 7 * MiB;
constexpr size_t WS_WUVT = 9 * MiB;
constexpr size_t WS_WSH = 9 * MiB + 256 * 1024;
constexpr size_t WS_ROPE = 10 * MiB;
constexpr size_t WS_WIDX = 11 * MiB;
constexpr size_t WS_CNT = 12 * MiB;
constexpr size_t WS_KIDX = 13 * MiB;
constexpr size_t WS_KV = 17 * MiB;
constexpr size_t WS_CQ = 27 * MiB;
constexpr size_t WS_CKVR = 43 * MiB;
constexpr size_t WS_SEL = 59 * MiB;
constexpr size_t WS_X16 = 75 * MiB;
constexpr size_t WS_Y = WS_X16;
constexpr size_t WS_U = 139 * MiB;
constexpr size_t WS_V = 171 * MiB;
constexpr size_t WS_ZA = 203 * MiB;
constexpr size_t WS_ZB = 235 * MiB;
constexpr size_t WS_QIDX = 267 * MiB;
constexpr size_t WS_QA = 299 * MiB;
constexpr size_t WS_A2 = 379 * MiB;
constexpr size_t WS_END = 443 * MiB;

struct Args {
    const float* x; const float* w_in; const float* pre_g; const float* post_g; const float* ln_g; const float* ln_b;
    const float* w_s; const float* b_s; const float* qn_g; const float* kvn_g; const float* w_uq; const float* w_uk;
    const float* w_uv; const float* w_qidx; const float* w_out;
    float* out; unsigned char* ws;
};

__device__ __forceinline__ float gelu_erf(float v) { return 0.5f * v * (1.0f + erff(v * 0.70710678118654752f)); }
__device__ __forceinline__ float silu(float v) { return v / (1.0f + __expf(-v)); }

__global__ __launch_bounds__(256) void prep_weights(Args a) {
    const int gtid = blockIdx.x * blockDim.x + threadIdx.x, gsz = gridDim.x * blockDim.x;
    unsigned char* ws = a.ws;
    h16* WinT = (h16*)(ws + WS_WINT);
    for (int i = gtid; i < NP * DM; i += gsz) {
        const int k = i / NP, n = i % NP, oc = old_col(n);
        WinT[(size_t)n * DM + k] = (h16)(oc >= 0 ? a.w_in[(size_t)k * NIN + oc] : 0.f);
    }
    h16* W2T = (h16*)(ws + WS_W2T);
    for (int i = gtid; i < N2 * QR; i += gsz) {
        const int k = i / N2, n = i % N2; float v;
        if (n < 1024) { const int h = n >> 7, c = n & 127; float s = 0.f;
            for (int d = 0; d < 64; ++d) s += a.w_uq[(size_t)k * 768 + h * 96 + d] * a.w_uk[(size_t)c * 512 + h * 64 + d];
            v = s;
        } else if (n < 1536) { v = a.w_qidx[(size_t)k * 512 + (n - 1024)]; }
        else { const int j = n - 1536, h = j >> 5, r = j & 31; v = a.w_uq[(size_t)k * 768 + h * 96 + 64 + r]; }
        W2T[(size_t)n * QR + k] = (h16)(v * a.qn_g[k]);
    }
    h16* WoutT = (h16*)(ws + WS_WOUTT);
    for (int i = gtid; i < DM * DM; i += gsz) { const int k = i / DM, n = i % DM; WoutT[(size_t)n * DM + k] = (h16)a.w_out[i]; }
    h16* WuvT = (h16*)(ws + WS_WUVT);
    for (int i = gtid; i < 128 * 512; i += gsz) { const int c = i / 512, hd = i % 512, h = hd >> 6, d = hd & 63; WuvT[(size_t)(h * 64 + d) * 128 + c] = (h16)a.w_uv[i]; }
    h16* WsH = (h16*)(ws + WS_WSH);
    for (int i = gtid; i < 4 * 128 * 128; i += gsz) { const int t = (i >> 7) & 127, s = i & 127; WsH[i] = (h16)(((s >> 6) <= (t >> 6)) ? a.w_s[i] : 0.f); }
    float2* rope = (float2*)(ws + WS_ROPE);
    for (int i = gtid; i < SEQ * 16; i += gsz) {
        const int pos = i >> 4, j = i & 15;
        const double invf = exp2(-(double)j * (13.287712379549449 / 16.0));
        const double ang = (double)pos * invf;
        const double n = rint(ang * 0.15915494309189535);
        const float r = (float)(ang - n * 6.283185307179586);
        rope[i] = make_float2(cosf(r), sinf(r));
    }
}

__global__ __launch_bounds__(256) void prep_x(Args a) {
    const int lane = threadIdx.x & 63, gw = (blockIdx.x * blockDim.x + threadIdx.x) >> 6, ngw = (gridDim.x * blockDim.x) >> 6;
    h16* X16 = (h16*)(a.ws + WS_X16);
    for (int row = gw; row < T; row += ngw) {
        const f32x4* xr = (const f32x4*)(a.x + (size_t)row * DM) + lane;
        f32x4 v[4]; float s = 0.f;
#pragma unroll
        for (int j = 0; j < 4; ++j) { v[j] = xr[64 * j]; s += (v[j].x * v[j].x + v[j].y * v[j].y) + (v[j].z * v[j].z + v[j].w * v[j].w); }
#pragma unroll
        for (int o = 1; o < 64; o <<= 1) s += __shfl_xor(s, o);
        const float rstd = rsqrtf(s * (1.f / DM) + EPS);
#pragma unroll
        for (int j = 0; j < 4; ++j) {
            const f32x4 g = *((const f32x4*)a.pre_g + lane + 64 * j);
            h16x4 o; o.x = (h16)(v[j].x * rstd * g.x); o.y = (h16)(v[j].y * rstd * g.y); o.z = (h16)(v[j].z * rstd * g.z); o.w = (h16)(v[j].w * rstd * g.w);
            *((h16x4*)(X16 + (size_t)row * DM) + lane + 64 * j) = o;
        }
    }
}

__global__ __launch_bounds__(256) void naive_proj(Args a) {
    __shared__ float xs[8][1024];
    __shared__ float os[8][NP];
    unsigned char* ws = a.ws;
    const h16* X16 = (const h16*)(ws + WS_X16); const h16* WinT = (const h16*)(ws + WS_WINT);
    const int tid = threadIdx.x, row0 = blockIdx.x * 8;
    for (int i = tid; i < 8 * 1024; i += 256) xs[i >> 10][i & 1023] = (float)X16[(size_t)(row0 + (i >> 10)) * DM + (i & 1023)];
    __syncthreads();
    for (int n = tid; n < NP; n += 256) {
        float acc[8] = {0.f, 0.f, 0.f, 0.f, 0.f, 0.f, 0.f, 0.f};
        const h16* w = WinT + (size_t)n * DM;
        for (int k = 0; k < DM; k += 8) { const h16x8 wv = *(const h16x8*)(w + k);
#pragma unroll
            for (int j = 0; j < 8; ++j) { const float wf = (float)wv[j];
#pragma unroll
                for (int r = 0; r < 8; ++r) acc[r] += xs[r][k + j] * wf; } }
#pragma unroll
        for (int r = 0; r < 8; ++r) os[r][n] = acc[r];
    }
    __syncthreads();
    h16* U = (h16*)(ws + WS_U); h16* V = (h16*)(ws + WS_V); h16* ZA = (h16*)(ws + WS_ZA); h16* ZB = (h16*)(ws + WS_ZB);
    h16* CQ = (h16*)(ws + WS_CQ); float* CKVR = (float*)(ws + WS_CKVR); h16* KV = (h16*)(ws + WS_KV); h16* KIDX = (h16*)(ws + WS_KIDX);
    float* WIDX = (float*)(ws + WS_WIDX); float* ssq = (float*)(ws + WS_SSQ); float* sskv = (float*)(ws + WS_SSKV);
    const float2* rope = (const float2*)(ws + WS_ROPE);
    for (int r = 0; r < 8; ++r) {
        const int tok = row0 + r, pos = tok & (SEQ - 1);
        for (int n = tid; n < NP; n += 256) {
            const float v = os[r][n];
            if (n < C_V) U[(size_t)tok * GW + n] = (h16)gelu_erf(v);
            else if (n < C_ZA) V[(size_t)tok * GW + n - C_V] = (h16)gelu_erf(v);
            else if (n < C_ZB) ZA[(size_t)tok * GW + n - C_ZA] = (h16)silu(v);
            else if (n < C_CQ) ZB[(size_t)tok * GW + n - C_ZB] = (h16)silu(v);
            else if (n < C_CKV) CQ[(size_t)tok * QR + n - C_CQ] = (h16)v;
            else if (n < C_KR) CKVR[(size_t)tok * CKV + n - C_CKV] = v;
            else if (n < C_KR + 16) { const int i = n - C_KR; const float x1 = v, x2 = os[r][n + 16]; const float2 cs = rope[pos * 16 + i];
                KV[(size_t)tok * KVD + CKV + i] = (h16)(x1 * cs.x - x2 * cs.y); KV[(size_t)tok * KVD + CKV + 16 + i] = (h16)(x2 * cs.x + x1 * cs.y); }
            else if (n < C_KI) {}
            else if (n < C_WI) KIDX[(size_t)tok * IDXD + n - C_KI] = (h16)v;
            else if (n < NIN) WIDX[(size_t)tok * NH + n - C_WI] = v * 0.044194173824159216f;
        }
        if (tid == 0) { float s = 0.f; for (int j = 0; j < QR; ++j) s += os[r][C_CQ + j] * os[r][C_CQ + j]; ssq[tok] = s; }
        if (tid == 64) { float s = 0.f; for (int j = 0; j < CKV; ++j) s += os[r][C_CKV + j] * os[r][C_CKV + j]; sskv[tok] = s; }
    }
}

__global__ __launch_bounds__(256) void naive_qproj(Args a) {
    __shared__ float cs_[8][QR];
    __shared__ float os[8][N2];
    unsigned char* ws = a.ws;
    const h16* CQ = (const h16*)(ws + WS_CQ); const h16* W2T = (const h16*)(ws + WS_W2T);
    const float* ssq = (const float*)(ws + WS_SSQ); const float* sskv = (const float*)(ws + WS_SSKV);
    const int tid = threadIdx.x, row0 = blockIdx.x * 8;
    for (int i = tid; i < 8 * QR; i += 256) cs_[i >> 8][i & 255] = (float)CQ[(size_t)(row0 + (i >> 8)) * QR + (i & 255)];
    __syncthreads();
    for (int n = tid; n < N2; n += 256) {
        float acc[8] = {0.f, 0.f, 0.f, 0.f, 0.f, 0.f, 0.f, 0.f};
        const h16* w = W2T + (size_t)n * QR;
        for (int k = 0; k < QR; k += 8) { const h16x8 wv = *(const h16x8*)(w + k);
#pragma unroll
            for (int j = 0; j < 8; ++j) { const float wf = (float)wv[j];
#pragma unroll
                for (int r = 0; r < 8; ++r) acc[r] += cs_[r][k + j] * wf; } }
#pragma unroll
        for (int r = 0; r < 8; ++r) os[r][n] = acc[r] * rsqrtf(ssq[row0 + r] * (1.f / QR) + EPS);
    }
    __syncthreads();
    h16* QA = (h16*)(ws + WS_QA); h16* QIDX = (h16*)(ws + WS_QIDX); h16* KV = (h16*)(ws + WS_KV); const float* CKVR = (const float*)(ws + WS_CKVR);
    const float2* rope = (const float2*)(ws + WS_ROPE);
    for (int r = 0; r < 8; ++r) {
        const int tok = row0 + r, pos = tok & (SEQ - 1);
        for (int n = tid; n < N2; n += 256) {
            const float v = os[r][n];
            if (n < 1024) QA[(size_t)tok * (NH * KVD) + (n >> 7) * KVD + (n & 127)] = (h16)v;
            else if (n < 1536) QIDX[(size_t)tok * 512 + n - 1024] = (h16)v;
            else { const int j = n - 1536, h = j >> 5, i = j & 31;
                if (i < 16) { const float x1 = v, x2 = os[r][n + 16]; const float2 cs = rope[pos * 16 + i];
                    QA[(size_t)tok * (NH * KVD) + h * KVD + CKV + i] = (h16)(x1 * cs.x - x2 * cs.y);
                    QA[(size_t)tok * (NH * KVD) + h * KVD + CKV + 16 + i] = (h16)(x2 * cs.x + x1 * cs.y); } }
        }
        if (tid < CKV) KV[(size_t)tok * KVD + tid] = (h16)(CKVR[(size_t)tok * CKV + tid] * rsqrtf(sskv[tok] * (1.f / CKV) + EPS) * a.kvn_g[tid]);
    }
}

__global__ __launch_bounds__(256) void naive_gmlp(Args a) {
    __shared__ float vn[128][128];
    __shared__ float mu[128], rs[128];
    unsigned char* ws = a.ws;
    const h16* U = (const h16*)(ws + WS_U); const h16* V = (const h16*)(ws + WS_V); const h16* ZA = (const h16*)(ws + WS_ZA);
    const h16* WsH = (const h16*)(ws + WS_WSH); h16* A2 = (h16*)(ws + WS_A2);
    const int tid = threadIdx.x, nb = blockIdx.x >> 2, g = blockIdx.x & 3, tok0 = nb * 128;
    if (tid < 128) { const h16* vr = V + (size_t)(tok0 + tid) * GW; float s = 0.f;
        for (int c = 0; c < GW; ++c) s += (float)vr[c];
        const float m = s * (1.f / GW); float q = 0.f;
        for (int c = 0; c < GW; ++c) { const float d = (float)vr[c] - m; q += d * d; }
        mu[tid] = m; rs[tid] = rsqrtf(q * (1.f / GW) + EPS); }
    __syncthreads();
    for (int i = tid; i < 128 * 128; i += 256) { const int s = i >> 7, c = i & 127, ch = g * 128 + c;
        vn[s][c] = (float)(h16)(((float)V[(size_t)(tok0 + s) * GW + ch] - mu[s]) * rs[s] * a.ln_g[ch] + a.ln_b[ch]); }
    __syncthreads();
    for (int i = tid; i < 128 * 128; i += 256) { const int t = i >> 7, c = i & 127, ch = g * 128 + c; float y = 0.f;
        const h16* w = WsH + (size_t)(g * 128 + t) * 128;
        for (int s = 0; s < 128; ++s) y += (float)w[s] * vn[s][c];
        y += a.b_s[g * 128 + t];
        const size_t o = (size_t)(tok0 + t) * GW + ch;
        A2[(size_t)(tok0 + t) * DM + ch] = (h16)((float)U[o] * y * (float)ZA[o]); }
}

__global__ __launch_bounds__(256) void naive_index(Args a) {
    __shared__ unsigned keys[SEQ];
    __shared__ float qs[512];
    __shared__ float wsd[8];
    __shared__ unsigned red[4];
    __shared__ unsigned cnt_s;
    unsigned char* ws = a.ws;
    const h16* QIDX = (const h16*)(ws + WS_QIDX); const h16* KIDX = (const h16*)(ws + WS_KIDX); const float* WIDX = (const float*)(ws + WS_WIDX);
    unsigned short* SEL = (unsigned short*)(ws + WS_SEL); int* CNT = (int*)(ws + WS_CNT);
    const int tid = threadIdx.x, tok = blockIdx.x, b = tok / SEQ, pos = tok % SEQ, N = ((pos >> 6) + 1) * 64;
    unsigned short* sel = SEL + (size_t)tok * TOPK;
    if (N <= TOPK) { if (tid < N) sel[tid] = (unsigned short)tid; if (tid == 0) CNT[tok] = N; return; }
    for (int i = tid; i < 512; i += 256) qs[i] = (float)QIDX[(size_t)tok * 512 + i];
    if (tid < 8) wsd[tid] = WIDX[(size_t)tok * 8 + tid];
    __syncthreads();
    for (int k = tid; k < N; k += 256) {
        const h16* kr = KIDX + (size_t)(b * SEQ + k) * IDXD; float kf[64];
#pragma unroll
        for (int j = 0; j < 8; ++j) { const h16x8 v = *(const h16x8*)(kr + 8 * j);
#pragma unroll
            for (int e = 0; e < 8; ++e) kf[8 * j + e] = (float)v[e]; }
        float sc = 0.f;
#pragma unroll
        for (int h = 0; h < 8; ++h) { float l = 0.f;
#pragma unroll
            for (int d = 0; d < 64; ++d) l += qs[h * 64 + d] * kf[d];
            sc += wsd[h] * fmaxf(l, 0.f); }
        unsigned u = __float_as_uint(sc); keys[k] = (u & 0x80000000u) ? ~u : (u | 0x80000000u);
    }
    __syncthreads();
    unsigned thr = 0u;
    for (int bit = 31; bit >= 0; --bit) {
        const unsigned cand = thr | (1u << bit); unsigned c = 0;
        for (int k = tid; k < N; k += 256) c += (keys[k] >= cand) ? 1u : 0u;
#pragma unroll
        for (int o = 1; o < 64; o <<= 1) c += __shfl_xor(c, o);
        if ((tid & 63) == 0) red[tid >> 6] = c;
        __syncthreads();
        const unsigned tot = red[0] + red[1] + red[2] + red[3];
        __syncthreads();
        if (tot >= (unsigned)TOPK) thr = cand;
    }
    if (tid == 0) cnt_s = 0u;
    __syncthreads();
    for (int k = tid; k < N; k += 256) if (keys[k] > thr) { const unsigned p = atomicAdd(&cnt_s, 1u); sel[p] = (unsigned short)k; }
    __syncthreads();
    if (tid == 0) { unsigned p = cnt_s; for (int k = 0; k < N && p < (unsigned)TOPK; ++k) if (keys[k] == thr) sel[p++] = (unsigned short)k; CNT[tok] = TOPK; }
}

__global__ __launch_bounds__(256) void naive_attn(Args a) {
    __shared__ h16 kvs[TOPK][CKV];
    __shared__ float ps[8][TOPK];
    __shared__ float qf[8][KVD];
    __shared__ float ol[8][CKV];
    __shared__ float redm[8][4], reds[8][4];
    unsigned char* ws = a.ws;
    const h16* QA = (const h16*)(ws + WS_QA); const h16* KV = (const h16*)(ws + WS_KV); const unsigned short* SEL = (const unsigned short*)(ws + WS_SEL);
    const int* CNT = (const int*)(ws + WS_CNT); const h16* WuvT = (const h16*)(ws + WS_WUVT); const h16* ZB = (const h16*)(ws + WS_ZB); h16* A2 = (h16*)(ws + WS_A2);
    const int tid = threadIdx.x, tok = blockIdx.x, b = tok / SEQ, cnt = CNT[tok];
    for (int i = tid; i < 8 * KVD; i += 256) qf[i / KVD][i % KVD] = (float)QA[(size_t)tok * (NH * KVD) + i];
    __syncthreads();
    float s[8];
    const bool act = tid < cnt;
    if (act) {
        const int kidx = SEL[(size_t)tok * TOPK + tid];
        const h16* kr = KV + (size_t)(b * SEQ + kidx) * KVD;
#pragma unroll
        for (int h = 0; h < 8; ++h) s[h] = 0.f;
        for (int j = 0; j < KVD / 8; ++j) { const h16x8 v = *(const h16x8*)(kr + 8 * j);
            if (j < CKV / 8) *(h16x8*)(&kvs[tid][8 * j]) = v;
#pragma unroll
            for (int e = 0; e < 8; ++e) { const float kf = (float)v[e];
#pragma unroll
                for (int h = 0; h < 8; ++h) s[h] += qf[h][8 * j + e] * kf; } }
#pragma unroll
        for (int h = 0; h < 8; ++h) s[h] *= 0.10206207261596577f;
    } else {
#pragma unroll
        for (int h = 0; h < 8; ++h) s[h] = -INFINITY;
    }
#pragma unroll
    for (int h = 0; h < 8; ++h) { float m = s[h];
#pragma unroll
        for (int o = 1; o < 64; o <<= 1) m = fmaxf(m, __shfl_xor(m, o));
        if ((tid & 63) == 0) redm[h][tid >> 6] = m; }
    __syncthreads();
    float p[8];
#pragma unroll
    for (int h = 0; h < 8; ++h) { const float m = fmaxf(fmaxf(redm[h][0], redm[h][1]), fmaxf(redm[h][2], redm[h][3]));
        p[h] = act ? __expf(s[h] - m) : 0.f; float t = p[h];
#pragma unroll
        for (int o = 1; o < 64; o <<= 1) t += __shfl_xor(t, o);
        if ((tid & 63) == 0) reds[h][tid >> 6] = t; }
    __syncthreads();
#pragma unroll
    for (int h = 0; h < 8; ++h) { const float l = (reds[h][0] + reds[h][1]) + (reds[h][2] + reds[h][3]); ps[h][tid] = (float)(h16)(p[h] / l); }
    __syncthreads();
    for (int i = tid; i < 8 * CKV; i += 256) { const int h = i >> 7, c = i & 127; float o = 0.f;
        for (int j = 0; j < cnt; ++j) o += ps[h][j] * (float)kvs[j][c];
        ol[h][c] = (float)(h16)o; }
    __syncthreads();
    for (int i = tid; i < 512; i += 256) { const int h = i >> 6; float o = 0.f; const h16* w = WuvT + (size_t)i * 128;
        for (int c = 0; c < CKV; ++c) o += ol[h][c] * (float)w[c];
        A2[(size_t)tok * DM + 512 + i] = (h16)(o * (float)ZB[(size_t)tok * GW + i]); }
}

__global__ __launch_bounds__(256) void naive_out(Args a) {
    __shared__ float as_[8][1024];
    __shared__ float red[8][4];
    unsigned char* ws = a.ws;
    const h16* A2 = (const h16*)(ws + WS_A2); const h16* WoutT = (const h16*)(ws + WS_WOUTT); h16* Y = (h16*)(ws + WS_Y); float* ssy = (float*)(ws + WS_SSY);
    const int tid = threadIdx.x, row0 = blockIdx.x * 8;
    for (int i = tid; i < 8 * 1024; i += 256) as_[i >> 10][i & 1023] = (float)A2[(size_t)(row0 + (i >> 10)) * DM + (i & 1023)];
    __syncthreads();
    float sq[8] = {0.f, 0.f, 0.f, 0.f, 0.f, 0.f, 0.f, 0.f};
    for (int n = tid; n < DM; n += 256) {
        float acc[8] = {0.f, 0.f, 0.f, 0.f, 0.f, 0.f, 0.f, 0.f};
        const h16* w = WoutT + (size_t)n * DM;
        for (int k = 0; k < DM; k += 8) { const h16x8 wv = *(const h16x8*)(w + k);
#pragma unroll
            for (int j = 0; j < 8; ++j) { const float wf = (float)wv[j];
#pragma unroll
                for (int r = 0; r < 8; ++r) acc[r] += as_[r][k + j] * wf; } }
#pragma unroll
        for (int r = 0; r < 8; ++r) { Y[(size_t)(row0 + r) * DM + n] = (h16)acc[r]; sq[r] += acc[r] * acc[r]; }
    }
#pragma unroll
    for (int r = 0; r < 8; ++r) { float t = sq[r];
#pragma unroll
        for (int o = 1; o < 64; o <<= 1) t += __shfl_xor(t, o);
        if ((tid & 63) == 0) red[r][tid >> 6] = t; }
    __syncthreads();
    if (tid < 8) ssy[row0 + tid] = (red[tid][0] + red[tid][1]) + (red[tid][2] + red[tid][3]);
}

__global__ __launch_bounds__(256) void final_out(Args a) {
    const h16* Y = (const h16*)(a.ws + WS_Y); const float* ssy = (const float*)(a.ws + WS_SSY);
    const size_t n4 = (size_t)T * DM / 4;
    for (size_t i = (size_t)blockIdx.x * blockDim.x + threadIdx.x; i < n4; i += (size_t)gridDim.x * blockDim.x) {
        const int row = (int)(i >> 8), c4 = (int)(i & 255);
        const float rstd = rsqrtf(ssy[row] * (1.f / DM) + EPS);
        const f32x4 xv = *((const f32x4*)a.x + i); const f32x4 g = *((const f32x4*)a.post_g + c4); const h16x4 yv = *((const h16x4*)Y + i);
        f32x4 o; o.x = xv.x + (float)yv.x * rstd * g.x; o.y = xv.y + (float)yv.y * rstd * g.y; o.z = xv.z + (float)yv.z * rstd * g.z; o.w = xv.w + (float)yv.w * rstd * g.w;
        *((f32x4*)a.out + i) = o;
    }
}

extern "C" void kernel_launch(void* const* d_in, const int* in_sizes, int n_in, void* d_out, int out_size, void* d_ws, size_t ws_size, hipStream_t stream) {
    if (n_in != 15 || ws_size < WS_END) { fprintf(stderr, "kernel_launch: unexpected n_in %d / ws %zu\n", n_in, ws_size); return; }
    Args a{};
    a.x = (const float*)d_in[0]; a.w_in = (const float*)d_in[1]; a.pre_g = (const float*)d_in[2]; a.post_g = (const float*)d_in[3];
    a.ln_g = (const float*)d_in[4]; a.ln_b = (const float*)d_in[5]; a.w_s = (const float*)d_in[6]; a.b_s = (const float*)d_in[7];
    a.qn_g = (const float*)d_in[8]; a.kvn_g = (const float*)d_in[9]; a.w_uq = (const float*)d_in[10]; a.w_uk = (const float*)d_in[11];
    a.w_uv = (const float*)d_in[12]; a.w_qidx = (const float*)d_in[13]; a.w_out = (const float*)d_in[14];
    a.out = (float*)d_out; a.ws = (unsigned char*)d_ws;
    hipLaunchKernelGGL(prep_weights, dim3(1024), dim3(256), 0, stream, a);
    hipLaunchKernelGGL(prep_x, dim3(2048), dim3(256), 0, stream, a);
    hipLaunchKernelGGL(naive_proj, dim3(T / 8), dim3(256), 0, stream, a);
    hipLaunchKernelGGL(naive_qproj, dim3(T / 8), dim3(256), 0, stream, a);
    hipLaunchKernelGGL(naive_gmlp, dim3(T / 128 * 4), dim3(256), 0, stream, a);
    hipLaunchKernelGGL(naive_index, dim3(T), dim3(256), 0, stream, a);
    hipLaunchKernelGGL(naive_attn, dim3(T), dim3(256), 0, stream, a);
    hipLaunchKernelGGL(naive_out, dim3(T / 8), dim3(256), 0, stream, a);
    hipLaunchKernelGGL(final_out, dim3(4096), dim3(256), 0, stream, a);
}
```

```cpp
#include <hip/hip_runtime.h>
#include <cstdio>
#include <cstdint>

typedef _Float16 h16;
typedef _Float16 h16x8 __attribute__((ext_vector_type(8)));
typedef _Float16 h16x4 __attribute__((ext_vector_type(4)));
typedef float f32x4 __attribute__((ext_vector_type(4)));

constexpr int BATCH = 4, SEQ = 8192, T = BATCH * SEQ, DM = 1024;
constexpr int NIN = 2536, NP = 2560;
constexpr int GW = 512;
constexpr int QR = 256, CKV = 128, ROPE = 32, IDXD = 64, NH = 8;
constexpr int KVD = CKV + ROPE;
constexpr int N2 = 1792;
constexpr int TOPK = 256;
constexpr float EPS = 1e-6f;
constexpr int C_U = 0, C_V = 512, C_ZA = 1024, C_ZB = 1536, C_CQ = 2048, C_CKV = 2304, C_KR = 2432, C_KI = 2464, C_WI = 2528;
__host__ __device__ inline int old_col(int n) {
    if (n < 1536) return n;
    if (n < 2048) return 2024 + (n - 1536);
    if (n < 2304) return 1536 + (n - 2048);
    if (n < 2432) return 1792 + (n - 2304);
    if (n < 2464) { const int rho = n - 2432; return 1920 + 16 * ((rho >> 2) & 1) + 4 * (rho >> 3) + (rho & 3); }
    if (n < 2528) return 1952 + (n - 2464);
    if (n < 2536) return 2016 + (n - 2528);
    return -1;
}

constexpr size_t MiB = 1u << 20;
constexpr size_t WS_CTL = 0;
constexpr size_t WS_SSQ = 64 * 1024;
constexpr size_t WS_SSKV = WS_SSQ + T * 4;
constexpr size_t WS_SSY = WS_SSKV + T * 4;
constexpr size_t WS_KMAX = WS_SSY + T * 4;
constexpr size_t WS_QUEUE = 4096;
constexpr size_t WS_WINT = 1 * MiB;
constexpr size_t WS_W2T = 6 * MiB;
constexpr size_t WS_WOUTT = 7 * MiB;
constexpr size_t WS_WUVT = 9 * MiB;
constexpr size_t WS_WSH = 9 * MiB + 256 * 1024;
constexpr size_t WS_ROPE = 10 * MiB;
constexpr size_t WS_WIDX = 11 * MiB;
constexpr size_t WS_CNT = 12 * MiB;
constexpr size_t WS_KIDX = 13 * MiB;
constexpr size_t WS_KV = 17 * MiB;
constexpr size_t WS_CQ = 27 * MiB;
constexpr size_t WS_CKVR = 43 * MiB;
constexpr size_t WS_SEL = 59 * MiB;
constexpr size_t WS_X16 = 75 * MiB;
constexpr size_t WS_Y = WS_X16;
constexpr size_t WS_U = 139 * MiB;
constexpr size_t WS_V = 171 * MiB;
constexpr size_t WS_ZA = 203 * MiB;
constexpr size_t WS_ZB = 235 * MiB;
constexpr size_t WS_QIDX = 267 * MiB;
constexpr size_t WS_QA = 299 * MiB;
constexpr size_t WS_A2 = 379 * MiB;
constexpr size_t WS_END = 443 * MiB;

struct Args {
    const float* x; const float* w_in; const float* pre_g; const float* post_g; const float* ln_g; const float* ln_b;
    const float* w_s; const float* b_s; const float* qn_g; const float* kvn_g; const float* w_uq; const float* w_uk;
    const float* w_uv; const float* w_qidx; const float* w_out;
    float* out; unsigned char* ws;
};

__device__ __forceinline__ float gelu_erf(float v) { return 0.5f * v * (1.0f + erff(v * 0.70710678118654752f)); }
__device__ __forceinline__ float silu(float v) { return v / (1.0f + __expf(-v)); }

__global__ __launch_bounds__(256) void prep_weights(Args a) {
    const int gtid = blockIdx.x * blockDim.x + threadIdx.x, gsz = gridDim.x * blockDim.x;
    unsigned char* ws = a.ws;
    h16* WinT = (h16*)(ws + WS_WINT);
    for (int i = gtid; i < NP * DM; i += gsz) {
        const int k = i / NP, n = i % NP, oc = old_col(n);
        WinT[(size_t)n * DM + k] = (h16)(oc >= 0 ? a.w_in[(size_t)k * NIN + oc] : 0.f);
    }
    h16* W2T = (h16*)(ws + WS_W2T);
    for (int i = gtid; i < N2 * QR; i += gsz) {
        const int k = i / N2, n = i % N2; float v;
        if (n < 1024) { const int h = n >> 7, c = n & 127; float s = 0.f;
            for (int d = 0; d < 64; ++d) s += a.w_uq[(size_t)k * 768 + h * 96 + d] * a.w_uk[(size_t)c * 512 + h * 64 + d];
            v = s;
        } else if (n < 1536) { v = a.w_qidx[(size_t)k * 512 + (n - 1024)]; }
        else { const int j = n - 1536, h = j >> 5, rho = j & 31, r = 16 * ((rho >> 2) & 1) + 4 * (rho >> 3) + (rho & 3); v = a.w_uq[(size_t)k * 768 + h * 96 + 64 + r]; }
        W2T[(size_t)n * QR + k] = (h16)(v * a.qn_g[k]);
    }
    h16* WoutT = (h16*)(ws + WS_WOUTT);
    for (int i = gtid; i < DM * DM; i += gsz) { const int k = i / DM, n = i % DM; WoutT[(size_t)n * DM + k] = (h16)a.w_out[i]; }
    h16* WuvT = (h16*)(ws + WS_WUVT);
    for (int i = gtid; i < 128 * 512; i += gsz) { const int c = i / 512, hd = i % 512, h = hd >> 6, d = hd & 63; WuvT[(size_t)(h * 64 + d) * 128 + c] = (h16)a.w_uv[i]; }
    h16* WsH = (h16*)(ws + WS_WSH);
    for (int i = gtid; i < 4 * 128 * 128; i += gsz) { const int t = (i >> 7) & 127, s = i & 127; WsH[i] = (h16)(((s >> 6) <= (t >> 6)) ? a.w_s[i] : 0.f); }
    float2* rope = (float2*)(ws + WS_ROPE);
    for (int i = gtid; i < SEQ * 16; i += gsz) {
        const int pos = i >> 4, j = i & 15;
        const double invf = exp2(-(double)j * (13.287712379549449 / 16.0));
        const double ang = (double)pos * invf;
        const double n = rint(ang * 0.15915494309189535);
        const float r = (float)(ang - n * 6.283185307179586);
        rope[i] = make_float2(cosf(r), sinf(r));
    }
}

__global__ __launch_bounds__(256) void prep_x(Args a) {
    const int lane = threadIdx.x & 63, gw = (blockIdx.x * blockDim.x + threadIdx.x) >> 6, ngw = (gridDim.x * blockDim.x) >> 6;
    h16* X16 = (h16*)(a.ws + WS_X16);
    for (int row = gw; row < T; row += ngw) {
        const f32x4* xr = (const f32x4*)(a.x + (size_t)row * DM) + lane;
        f32x4 v[4]; float s = 0.f;
#pragma unroll
        for (int j = 0; j < 4; ++j) { v[j] = xr[64 * j]; s += (v[j].x * v[j].x + v[j].y * v[j].y) + (v[j].z * v[j].z + v[j].w * v[j].w); }
#pragma unroll
        for (int o = 1; o < 64; o <<= 1) s += __shfl_xor(s, o);
        const float rstd = rsqrtf(s * (1.f / DM) + EPS);
#pragma unroll
        for (int j = 0; j < 4; ++j) {
            const f32x4 g = *((const f32x4*)a.pre_g + lane + 64 * j);
            h16x4 o; o.x = (h16)(v[j].x * rstd * g.x); o.y = (h16)(v[j].y * rstd * g.y); o.z = (h16)(v[j].z * rstd * g.z); o.w = (h16)(v[j].w * rstd * g.w);
            *((h16x4*)(X16 + (size_t)row * DM) + lane + 64 * j) = o;
        }
    }
}

__global__ __launch_bounds__(256) void naive_proj(Args a) {
    __shared__ float xs[8][1024];
    __shared__ float os[8][NP];
    unsigned char* ws = a.ws;
    const h16* X16 = (const h16*)(ws + WS_X16); const h16* WinT = (const h16*)(ws + WS_WINT);
    const int tid = threadIdx.x, row0 = blockIdx.x * 8;
    for (int i = tid; i < 8 * 1024; i += 256) xs[i >> 10][i & 1023] = (float)X16[(size_t)(row0 + (i >> 10)) * DM + (i & 1023)];
    __syncthreads();
    for (int n = tid; n < NP; n += 256) {
        float acc[8] = {0.f, 0.f, 0.f, 0.f, 0.f, 0.f, 0.f, 0.f};
        const h16* w = WinT + (size_t)n * DM;
        for (int k = 0; k < DM; k += 8) { const h16x8 wv = *(const h16x8*)(w + k);
#pragma unroll
            for (int j = 0; j < 8; ++j) { const float wf = (float)wv[j];
#pragma unroll
                for (int r = 0; r < 8; ++r) acc[r] += xs[r][k + j] * wf; } }
#pragma unroll
        for (int r = 0; r < 8; ++r) os[r][n] = acc[r];
    }
    __syncthreads();
    h16* U = (h16*)(ws + WS_U); h16* V = (h16*)(ws + WS_V); h16* ZA = (h16*)(ws + WS_ZA); h16* ZB = (h16*)(ws + WS_ZB);
    h16* CQ = (h16*)(ws + WS_CQ); float* CKVR = (float*)(ws + WS_CKVR); h16* KV = (h16*)(ws + WS_KV); h16* KIDX = (h16*)(ws + WS_KIDX);
    float* WIDX = (float*)(ws + WS_WIDX); float* ssq = (float*)(ws + WS_SSQ); float* sskv = (float*)(ws + WS_SSKV);
    const float2* rope = (const float2*)(ws + WS_ROPE);
    for (int r = 0; r < 8; ++r) {
        const int tok = row0 + r, pos = tok & (SEQ - 1);
        for (int n = tid; n < NP; n += 256) {
            const float v = os[r][n];
            if (n < C_V) U[(size_t)tok * GW + n] = (h16)gelu_erf(v);
            else if (n < C_ZA) V[(size_t)tok * GW + n - C_V] = (h16)gelu_erf(v);
            else if (n < C_ZB) ZA[(size_t)tok * GW + n - C_ZA] = (h16)silu(v);
            else if (n < C_CQ) ZB[(size_t)tok * GW + n - C_ZB] = (h16)silu(v);
            else if (n < C_CKV) CQ[(size_t)tok * QR + n - C_CQ] = (h16)v;
            else if (n < C_KR) CKVR[(size_t)tok * CKV + n - C_CKV] = v;
            else if (n < C_KR + 16) { const int i = n - C_KR; const float x1 = v, x2 = os[r][n + 16]; const float2 cs = rope[pos * 16 + i];
                KV[(size_t)tok * KVD + CKV + i] = (h16)(x1 * cs.x - x2 * cs.y); KV[(size_t)tok * KVD + CKV + 16 + i] = (h16)(x2 * cs.x + x1 * cs.y); }
            else if (n < C_KI) {}
            else if (n < C_WI) KIDX[(size_t)tok * IDXD + n - C_KI] = (h16)v;
            else if (n < NIN) WIDX[(size_t)tok * NH + n - C_WI] = v * 0.044194173824159216f;
        }
        if (tid == 0) { float s = 0.f; for (int j = 0; j < QR; ++j) s += os[r][C_CQ + j] * os[r][C_CQ + j]; ssq[tok] = s; }
        if (tid == 64) { float s = 0.f; for (int j = 0; j < CKV; ++j) s += os[r][C_CKV + j] * os[r][C_CKV + j]; sskv[tok] = s; }
    }
}

__global__ __launch_bounds__(256) void naive_qproj(Args a) {
    __shared__ float cs_[8][QR];
    __shared__ float os[8][N2];
    unsigned char* ws = a.ws;
    const h16* CQ = (const h16*)(ws + WS_CQ); const h16* W2T = (const h16*)(ws + WS_W2T);
    const float* ssq = (const float*)(ws + WS_SSQ); const float* sskv = (const float*)(ws + WS_SSKV);
    const int tid = threadIdx.x, row0 = blockIdx.x * 8;
    for (int i = tid; i < 8 * QR; i += 256) cs_[i >> 8][i & 255] = (float)CQ[(size_t)(row0 + (i >> 8)) * QR + (i & 255)];
    __syncthreads();
    for (int n = tid; n < N2; n += 256) {
        float acc[8] = {0.f, 0.f, 0.f, 0.f, 0.f, 0.f, 0.f, 0.f};
        const h16* w = W2T + (size_t)n * QR;
        for (int k = 0; k < QR; k += 8) { const h16x8 wv = *(const h16x8*)(w + k);
#pragma unroll
            for (int j = 0; j < 8; ++j) { const float wf = (float)wv[j];
#pragma unroll
                for (int r = 0; r < 8; ++r) acc[r] += cs_[r][k + j] * wf; } }
#pragma unroll
        for (int r = 0; r < 8; ++r) os[r][n] = acc[r] * rsqrtf(ssq[row0 + r] * (1.f / QR) + EPS);
    }
    __syncthreads();
    h16* QA = (h16*)(ws + WS_QA); h16* QIDX = (h16*)(ws + WS_QIDX); h16* KV = (h16*)(ws + WS_KV); const float* CKVR = (const float*)(ws + WS_CKVR);
    const float2* rope = (const float2*)(ws + WS_ROPE);
    for (int r = 0; r < 8; ++r) {
        const int tok = row0 + r, pos = tok & (SEQ - 1);
        for (int n = tid; n < N2; n += 256) {
            const float v = os[r][n];
            if (n < 1024) QA[(size_t)tok * (NH * KVD) + (n >> 7) * KVD + (n & 127)] = (h16)v;
            else if (n < 1536) QIDX[(size_t)tok * 512 + n - 1024] = (h16)v;
            else { const int j = n - 1536, h = j >> 5, i = j & 31;
                if (i < 16) { const float x1 = v, x2 = os[r][n + 16]; const float2 cs = rope[pos * 16 + i];
                    QA[(size_t)tok * (NH * KVD) + h * KVD + CKV + i] = (h16)(x1 * cs.x - x2 * cs.y);
                    QA[(size_t)tok * (NH * KVD) + h * KVD + CKV + 16 + i] = (h16)(x2 * cs.x + x1 * cs.y); } }
        }
        if (tid < CKV) KV[(size_t)tok * KVD + tid] = (h16)(CKVR[(size_t)tok * CKV + tid] * rsqrtf(sskv[tok] * (1.f / CKV) + EPS) * a.kvn_g[tid]);
    }
}

__global__ __launch_bounds__(256) void naive_gmlp(Args a) {
    __shared__ float vn[128][128];
    __shared__ float mu[128], rs[128];
    unsigned char* ws = a.ws;
    const h16* U = (const h16*)(ws + WS_U); const h16* V = (const h16*)(ws + WS_V); const h16* ZA = (const h16*)(ws + WS_ZA);
    const h16* WsH = (const h16*)(ws + WS_WSH); h16* A2 = (h16*)(ws + WS_A2);
    const int tid = threadIdx.x, nb = blockIdx.x >> 2, g = blockIdx.x & 3, tok0 = nb * 128;
    if (tid < 128) { const h16* vr = V + (size_t)(tok0 + tid) * GW; float s = 0.f;
        for (int c = 0; c < GW; ++c) s += (float)vr[c];
        const float m = s * (1.f / GW); float q = 0.f;
        for (int c = 0; c < GW; ++c) { const float d = (float)vr[c] - m; q += d * d; }
        mu[tid] = m; rs[tid] = rsqrtf(q * (1.f / GW) + EPS); }
    __syncthreads();
    for (int i = tid; i < 128 * 128; i += 256) { const int s = i >> 7, c = i & 127, ch = g * 128 + c;
        vn[s][c] = (float)(h16)(((float)V[(size_t)(tok0 + s) * GW + ch] - mu[s]) * rs[s] * a.ln_g[ch] + a.ln_b[ch]); }
    __syncthreads();
    for (int i = tid; i < 128 * 128; i += 256) { const int t = i >> 7, c = i & 127, ch = g * 128 + c; float y = 0.f;
        const h16* w = WsH + (size_t)(g * 128 + t) * 128;
        for (int s = 0; s < 128; ++s) y += (float)w[s] * vn[s][c];
        y += a.b_s[g * 128 + t];
        const size_t o = (size_t)(tok0 + t) * GW + ch;
        A2[(size_t)(tok0 + t) * DM + ch] = (h16)((float)U[o] * y * (float)ZA[o]); }
}

__global__ __launch_bounds__(256) void naive_index(Args a) {
    __shared__ unsigned keys[SEQ];
    __shared__ float qs[512];
    __shared__ float wsd[8];
    __shared__ unsigned red[4];
    __shared__ unsigned cnt_s;
    unsigned char* ws = a.ws;
    const h16* QIDX = (const h16*)(ws + WS_QIDX); const h16* KIDX = (const h16*)(ws + WS_KIDX); const float* WIDX = (const float*)(ws + WS_WIDX);
    unsigned short* SEL = (unsigned short*)(ws + WS_SEL); int* CNT = (int*)(ws + WS_CNT);
    const int tid = threadIdx.x, tok = blockIdx.x, b = tok / SEQ, pos = tok % SEQ, N = ((pos >> 6) + 1) * 64;
    unsigned short* sel = SEL + (size_t)tok * TOPK;
    if (N <= TOPK) { if (tid < N) sel[tid] = (unsigned short)tid; if (tid == 0) CNT[tok] = N; return; }
    for (int i = tid; i < 512; i += 256) qs[i] = (float)QIDX[(size_t)tok * 512 + i];
    if (tid < 8) wsd[tid] = WIDX[(size_t)tok * 8 + tid];
    __syncthreads();
    for (int k = tid; k < N; k += 256) {
        const h16* kr = KIDX + (size_t)(b * SEQ + k) * IDXD; float kf[64];
#pragma unroll
        for (int j = 0; j < 8; ++j) { const h16x8 v = *(const h16x8*)(kr + 8 * j);
#pragma unroll
            for (int e = 0; e < 8; ++e) kf[8 * j + e] = (float)v[e]; }
        float sc = 0.f;
#pragma unroll
        for (int h = 0; h < 8; ++h) { float l = 0.f;
#pragma unroll
            for (int d = 0; d < 64; ++d) l += qs[h * 64 + d] * kf[d];
            sc += wsd[h] * fmaxf(l, 0.f); }
        unsigned u = __float_as_uint(sc); keys[k] = (u & 0x80000000u) ? ~u : (u | 0x80000000u);
    }
    __syncthreads();
    unsigned thr = 0u;
    for (int bit = 31; bit >= 0; --bit) {
        const unsigned cand = thr | (1u << bit); unsigned c = 0;
        for (int k = tid; k < N; k += 256) c += (keys[k] >= cand) ? 1u : 0u;
#pragma unroll
        for (int o = 1; o < 64; o <<= 1) c += __shfl_xor(c, o);
        if ((tid & 63) == 0) red[tid >> 6] = c;
        __syncthreads();
        const unsigned tot = red[0] + red[1] + red[2] + red[3];
        __syncthreads();
        if (tot >= (unsigned)TOPK) thr = cand;
    }
    if (tid == 0) cnt_s = 0u;
    __syncthreads();
    for (int k = tid; k < N; k += 256) if (keys[k] > thr) { const unsigned p = atomicAdd(&cnt_s, 1u); sel[p] = (unsigned short)k; }
    __syncthreads();
    if (tid == 0) { unsigned p = cnt_s; for (int k = 0; k < N && p < (unsigned)TOPK; ++k) if (keys[k] == thr) sel[p++] = (unsigned short)k; CNT[tok] = TOPK; }
}

__global__ __launch_bounds__(256) void naive_attn(Args a) {
    __shared__ h16 kvs[TOPK][CKV];
    __shared__ float ps[8][TOPK];
    __shared__ float qf[8][KVD];
    __shared__ float ol[8][CKV];
    __shared__ float redm[8][4], reds[8][4];
    unsigned char* ws = a.ws;
    const h16* QA = (const h16*)(ws + WS_QA); const h16* KV = (const h16*)(ws + WS_KV); const unsigned short* SEL = (const unsigned short*)(ws + WS_SEL);
    const int* CNT = (const int*)(ws + WS_CNT); const h16* WuvT = (const h16*)(ws + WS_WUVT); const h16* ZB = (const h16*)(ws + WS_ZB); h16* A2 = (h16*)(ws + WS_A2);
    const int tid = threadIdx.x, tok = blockIdx.x, b = tok / SEQ, cnt = CNT[tok];
    for (int i = tid; i < 8 * KVD; i += 256) qf[i / KVD][i % KVD] = (float)QA[(size_t)tok * (NH * KVD) + i];
    __syncthreads();
    float s[8];
    const bool act = tid < cnt;
    if (act) {
        const int kidx = SEL[(size_t)tok * TOPK + tid];
        const h16* kr = KV + (size_t)(b * SEQ + kidx) * KVD;
#pragma unroll
        for (int h = 0; h < 8; ++h) s[h] = 0.f;
        for (int j = 0; j < KVD / 8; ++j) { const h16x8 v = *(const h16x8*)(kr + 8 * j);
            if (j < CKV / 8) *(h16x8*)(&kvs[tid][8 * j]) = v;
#pragma unroll
            for (int e = 0; e < 8; ++e) { const float kf = (float)v[e];
#pragma unroll
                for (int h = 0; h < 8; ++h) s[h] += qf[h][8 * j + e] * kf; } }
#pragma unroll
        for (int h = 0; h < 8; ++h) s[h] *= 0.10206207261596577f;
    } else {
#pragma unroll
        for (int h = 0; h < 8; ++h) s[h] = -INFINITY;
    }
#pragma unroll
    for (int h = 0; h < 8; ++h) { float m = s[h];
#pragma unroll
        for (int o = 1; o < 64; o <<= 1) m = fmaxf(m, __shfl_xor(m, o));
        if ((tid & 63) == 0) redm[h][tid >> 6] = m; }
    __syncthreads();
    float p[8];
#pragma unroll
    for (int h = 0; h < 8; ++h) { const float m = fmaxf(fmaxf(redm[h][0], redm[h][1]), fmaxf(redm[h][2], redm[h][3]));
        p[h] = act ? __expf(s[h] - m) : 0.f; float t = p[h];
#pragma unroll
        for (int o = 1; o < 64; o <<= 1) t += __shfl_xor(t, o);
        if ((tid & 63) == 0) reds[h][tid >> 6] = t; }
    __syncthreads();
#pragma unroll
    for (int h = 0; h < 8; ++h) { const float l = (reds[h][0] + reds[h][1]) + (reds[h][2] + reds[h][3]); ps[h][tid] = (float)(h16)(p[h] / l); }
    __syncthreads();
    for (int i = tid; i < 8 * CKV; i += 256) { const int h = i >> 7, c = i & 127; float o = 0.f;
        for (int j = 0; j < cnt; ++j) o += ps[h][j] * (float)kvs[j][c];
        ol[h][c] = (float)(h16)o; }
    __syncthreads();
    for (int i = tid; i < 512; i += 256) { const int h = i >> 6; float o = 0.f; const h16* w = WuvT + (size_t)i * 128;
        for (int c = 0; c < CKV; ++c) o += ol[h][c] * (float)w[c];
        A2[(size_t)tok * DM + 512 + i] = (h16)(o * (float)ZB[(size_t)tok * GW + i]); }
}


namespace pg8 {
#define PG8_LAS __attribute__((address_space(3)))
typedef unsigned u32x4 __attribute__((ext_vector_type(4)));
typedef float f32x2 __attribute__((ext_vector_type(2)));
constexpr int BM = 256, BK = 64, HALF = 128, HTB = HALF * BK * 2, STAGE_BYTES = 8 * HTB, NXCD = 8, WGM = 8;
__host__ __device__ __forceinline__ int lds_byte(int r, int c) { const int st = (r >> 4) * 2 + (c >> 5), rr = r & 15, cc = c & 31, ob = rr * 64 + cc * 2; return st * 1024 + (ob ^ (((ob >> 9) & 1) << 5)); }
__host__ __device__ __forceinline__ void stage_rc(int b, int& R, int& C) { const int st = b / 1024, sb = b % 1024, swz = sb ^ (((sb >> 9) & 1) << 5); R = (st >> 1) * 16 + swz / 64; C = (st & 1) * 32 + (swz % 64) / 2; }
__host__ __device__ __forceinline__ int perm32(int rho) { const int n = rho >> 4, i = rho & 15; return 8 * (i >> 2) + 4 * n + (i & 3); }
struct Unit { int pm, pn; };
struct Gemm { const h16* A; const h16* Bt; int M, N, K; };
struct StaticOrder {
    int nM, nN, nwg, G, c;
    __host__ __device__ void init(int M, int N, int G_, int c_) { nM = M / BM; nN = N / BM; nwg = nM * nN; G = G_; c = c_; }
    __host__ __device__ bool next(int i, Unit& u) const {
        const long L = (long)i * G + c; if (L >= nwg) return false;
        int wgid = (int)L; { const int q = nwg / NXCD, r = nwg % NXCD, xcd = wgid % NXCD, off = wgid / NXCD; wgid = (xcd < r ? xcd * (q + 1) : r * (q + 1) + (xcd - r) * q) + off; }
        const int nig = WGM * nN, gid = wgid / nig, fm = gid * WGM, gsz = (nM - fm) < WGM ? (nM - fm) : WGM;
        u.pm = fm + ((wgid % nig) % gsz); u.pn = (wgid % nig) / gsz; return true;
    }
};
__device__ __forceinline__ f32x2 gelu_pk(f32x2 v) {
    const f32x2 av = __builtin_elementwise_abs(v), d = av * 0.2316418882f + 1.0f;
    f32x2 t; t.x = __builtin_amdgcn_rcpf(d.x); t.y = __builtin_amdgcn_rcpf(d.y);
    f32x2 q = t * 0.5307027145f + (-0.7265760135f); q = q * t + 0.7107068705f; q = q * t + (-0.142248368f); q = q * t + 0.127414796f; q = q * t;
    const f32x2 s = (v * v) * (-0.72134752044f);
    f32x2 e; e.x = __builtin_amdgcn_exp2f(s.x); e.y = __builtin_amdgcn_exp2f(s.y);
    const f32x2 m = v * (q * e), r = v - m;
    f32x2 o; o.x = v.x < 0.f ? m.x : r.x; o.y = v.y < 0.f ? m.y : r.y; return o;
}
__device__ __forceinline__ unsigned pk_h2(float lo, float hi) { typedef _Float16 h2 __attribute__((ext_vector_type(2))); h2 v; v.x = (h16)lo; v.y = (h16)hi; return __builtin_bit_cast(unsigned, v); }
__device__ __forceinline__ u32x4 pk_h8(f32x4 a, f32x4 b) { u32x4 w; w.x = pk_h2(a[0], a[1]); w.y = pk_h2(a[2], a[3]); w.z = pk_h2(b[0], b[1]); w.w = pk_h2(b[2], b[3]); return w; }

template <class Epi, bool ALIGN_EPI = true>
__device__ __forceinline__ void gemm_phase(PG8_LAS unsigned char* lds, const Gemm g, const StaticOrder& S, const Epi& E) {
    const int tid = threadIdx.x, wid = __builtin_amdgcn_readfirstlane(tid >> 6), lane = tid & 63, wr = wid >> 2, wc = wid & 3, fr = lane & 15, fq = lane >> 4;
    const int K = g.K, nt = K / BK;
    unsigned voffA[2], voffB[2];
#pragma unroll
    for (int i = 0; i < 2; ++i) { int R, C; stage_rc(tid * 16 + i * 8192, R, C); const int Rb = (R & ~31) + perm32(R & 31);
        voffA[i] = (unsigned)(R * K + C) * 2u; voffB[i] = (unsigned)(Rb * K + C) * 2u; }
    const size_t kstep = (size_t)(BK * 2);
    const size_t hstep = (size_t)HALF * K * 2;
    const size_t tstep = 2 * hstep;
    const unsigned ldsw = (unsigned)wid * 1024u;
    const int aoff = lds_byte(wr * 64 + fr, fq * 8), boff = lds_byte(wc * 32 + fr, fq * 8);
#define PG8_SA(b, h) (((b) * 2 + (h)) * HTB)
#define PG8_SB(b, h) ((4 + (b) * 2 + (h)) * HTB)
#define PG8_STAGE(bufoff, gbase, voff) do { _Pragma("unroll") for (int _i = 0; _i < 2; ++_i) \
        __builtin_amdgcn_global_load_lds((const unsigned*)((const char*)(gbase) + (voff)[_i]), (PG8_LAS unsigned*)(lds + (bufoff) + ldsw + _i * 8192), 16, 0, 0); } while (0)
#define PG8_LDA(dst, b, h) do { _Pragma("unroll") for (int m = 0; m < 4; ++m) _Pragma("unroll") for (int k = 0; k < 2; ++k) dst[m][k] = *(const PG8_LAS h16x8*)(lds + PG8_SA(b, h) + aoff + m * 2048 + k * 1024); } while (0)
#define PG8_LDB(dst, b, h) do { _Pragma("unroll") for (int n = 0; n < 2; ++n) _Pragma("unroll") for (int k = 0; k < 2; ++k) dst[n][k] = *(const PG8_LAS h16x8*)(lds + PG8_SB(b, h) + boff + n * 2048 + k * 1024); } while (0)
#define PG8_MMA(ai, bj, At, Bt) do { __builtin_amdgcn_s_setprio(1); _Pragma("unroll") for (int m = 0; m < 4; ++m) _Pragma("unroll") for (int n = 0; n < 2; ++n) _Pragma("unroll") for (int k = 0; k < 2; ++k) \
        acc[ai][bj][m][n] = __builtin_amdgcn_mfma_f32_16x16x32_f16(Bt[n][k], At[m][k], acc[ai][bj][m][n], 0, 0, 0); __builtin_amdgcn_s_setprio(0); } while (0)
#define PG8_WAIT_V(n) asm volatile("s_waitcnt vmcnt(" #n ")" ::: "memory")
#define PG8_WAIT_L(n) asm volatile("s_waitcnt lgkmcnt(" #n ")" ::: "memory")
#define PG8_BAR __builtin_amdgcn_s_barrier()
#define PG8_SCHED __builtin_amdgcn_sched_barrier(0)
    Unit cur, nxt; int ui = 0;
    if (!S.next(0, cur)) return;
    f32x4 acc[2][2][4][2];
#pragma unroll
    for (int a = 0; a < 2; ++a)
#pragma unroll
        for (int b = 0; b < 2; ++b)
#pragma unroll
            for (int m = 0; m < 4; ++m)
#pragma unroll
                for (int n = 0; n < 2; ++n) acc[a][b][m][n] = (f32x4){0.f, 0.f, 0.f, 0.f};
    h16x8 At[4][2], B0[2][2], B1[2][2];
    const char* cA = (const char*)g.A + (size_t)cur.pm * tstep; const char* cB = (const char*)g.Bt + (size_t)cur.pn * tstep;
    PG8_STAGE(PG8_SB(0, 0), cB, voffB); PG8_STAGE(PG8_SB(0, 1), cB + hstep, voffB); PG8_STAGE(PG8_SA(0, 0), cA, voffA); PG8_STAGE(PG8_SA(0, 1), cA + hstep, voffA);
    if (wr == 1) PG8_BAR;
    PG8_WAIT_V(2); PG8_BAR;
    PG8_STAGE(PG8_SB(1, 0), cB + kstep, voffB); PG8_STAGE(PG8_SA(1, 0), cA + kstep, voffA); PG8_STAGE(PG8_SB(1, 1), cB + hstep + kstep, voffB);
    PG8_WAIT_V(6); PG8_BAR;
    for (;;) {
        const bool has_next = S.next(ui + 1, nxt);
        const char* nA = has_next ? (const char*)g.A + (size_t)nxt.pm * tstep : cA; const char* nB = has_next ? (const char*)g.Bt + (size_t)nxt.pn * tstep : cB;
        for (int t = 0; t < nt; t += 2) {
            const bool last = (t == nt - 2);
            const char* a1 = cA + (size_t)(t + 1) * kstep;
            const char* a2 = last ? nA : cA + (size_t)(t + 2) * kstep; const char* b2 = last ? nB : cB + (size_t)(t + 2) * kstep;
            const char* a3 = a2 + kstep; const char* b3 = b2 + kstep;
            PG8_LDB(B0, 0, 0); PG8_LDB(B1, 0, 1); PG8_SCHED; PG8_LDA(At, 0, 0); PG8_STAGE(PG8_SA(1, 1), a1 + hstep, voffA);
            PG8_WAIT_V(8); PG8_WAIT_L(0); PG8_BAR; PG8_MMA(0, 0, At, B0); PG8_MMA(0, 1, At, B1); PG8_BAR; PG8_SCHED;
            PG8_LDA(At, 0, 1); PG8_STAGE(PG8_SB(0, 0), b2, voffB); PG8_STAGE(PG8_SB(0, 1), b2 + hstep, voffB); PG8_STAGE(PG8_SA(0, 0), a2, voffA);
            PG8_WAIT_V(8); PG8_WAIT_L(0); PG8_BAR; PG8_MMA(1, 0, At, B0); PG8_MMA(1, 1, At, B1); PG8_BAR; PG8_SCHED;
            PG8_LDB(B0, 1, 0); PG8_LDB(B1, 1, 1); PG8_SCHED; PG8_LDA(At, 1, 0); PG8_STAGE(PG8_SA(0, 1), a2 + hstep, voffA);
            PG8_WAIT_V(8); PG8_WAIT_L(0); PG8_BAR; PG8_MMA(0, 0, At, B0); PG8_MMA(0, 1, At, B1); PG8_BAR; PG8_SCHED;
            PG8_LDA(At, 1, 1); PG8_STAGE(PG8_SB(1, 0), b3, voffB); PG8_STAGE(PG8_SB(1, 1), b3 + hstep, voffB); PG8_STAGE(PG8_SA(1, 0), a3, voffA);
            PG8_WAIT_V(8); PG8_WAIT_L(0); PG8_BAR; PG8_MMA(1, 0, At, B0); PG8_MMA(1, 1, At, B1); PG8_BAR; PG8_SCHED;
        }
        if constexpr (ALIGN_EPI) { if (wr == 0) PG8_BAR; }
        E(acc, cur, wr, wc, fr, fq);
        if (!has_next) break;
#pragma unroll
        for (int a = 0; a < 2; ++a)
#pragma unroll
            for (int b = 0; b < 2; ++b)
#pragma unroll
                for (int m = 0; m < 4; ++m)
#pragma unroll
                    for (int n = 0; n < 2; ++n) acc[a][b][m][n] = (f32x4){0.f, 0.f, 0.f, 0.f};
        cur = nxt; cA = nA; cB = nB; ++ui;
        if constexpr (ALIGN_EPI) { if (wr == 1) PG8_BAR; }
    }
    PG8_WAIT_V(0);
    if constexpr (!ALIGN_EPI) { if (wr == 0) PG8_BAR; }
    PG8_BAR;
#undef PG8_SA
#undef PG8_SB
#undef PG8_STAGE
#undef PG8_LDA
#undef PG8_LDB
#undef PG8_MMA
#undef PG8_WAIT_V
#undef PG8_WAIT_L
#undef PG8_BAR
#undef PG8_SCHED
}

struct EpiOut {
    h16* Y; float* ssy;
    __device__ __forceinline__ void operator()(const f32x4 (&acc)[2][2][4][2], const Unit& u, int wr, int wc, int fr, int fq) const {
        const int row0 = u.pm * BM + wr * 64 + fr, col0 = u.pn * BM + wc * 32 + 8 * fq;
#pragma unroll
        for (int ai = 0; ai < 2; ++ai)
#pragma unroll
            for (int m = 0; m < 4; ++m) { const int row = row0 + ai * HALF + m * 16; h16* rowp = Y + (size_t)row * DM + col0; float s = 0.f;
#pragma unroll
                for (int bj = 0; bj < 2; ++bj) { const f32x4 v0 = acc[ai][bj][m][0], v1 = acc[ai][bj][m][1];
                    s += (v0[0] * v0[0] + v0[1] * v0[1]) + (v0[2] * v0[2] + v0[3] * v0[3]) + (v1[0] * v1[0] + v1[1] * v1[1]) + (v1[2] * v1[2] + v1[3] * v1[3]);
                    *(u32x4*)(rowp + bj * HALF) = pk_h8(v0, v1); }
                s += __shfl_xor(s, 16); s += __shfl_xor(s, 32);
                if (fq == 0) atomicAdd(ssy + row, s); }
    }
};

__device__ __forceinline__ float silu_f(float v) { return v * __builtin_amdgcn_rcpf(1.0f + __builtin_amdgcn_exp2f(-1.4426950408889634f * v)); }
struct EpiProj {
    h16 *U, *V, *ZA, *ZB, *CQ, *KV, *KIDX; float *CKVR, *WIDX, *ssq, *sskv; const float* rope;
    __device__ __forceinline__ void operator()(const f32x4 (&acc)[2][2][4][2], const Unit& u, int wr, int wc, int fr, int fq) const {
        const int row0 = u.pm * BM + wr * 64 + fr, pn = u.pn;
        if (pn < 8) {
            h16* base = (pn < 2 ? U : pn < 4 ? V : pn < 6 ? ZA : ZB) + (pn & 1) * 256 + wc * 32 + 8 * fq;
            const bool is_gelu = pn < 4;
#pragma unroll
            for (int ai = 0; ai < 2; ++ai)
#pragma unroll
                for (int m = 0; m < 4; ++m) { h16* rowp = base + (size_t)(row0 + ai * HALF + m * 16) * GW;
#pragma unroll
                    for (int bj = 0; bj < 2; ++bj) { f32x4 v0 = acc[ai][bj][m][0], v1 = acc[ai][bj][m][1];
                        if (is_gelu) { const f32x2 a = gelu_pk((f32x2){v0[0], v0[1]}), b = gelu_pk((f32x2){v0[2], v0[3]}), c = gelu_pk((f32x2){v1[0], v1[1]}), d = gelu_pk((f32x2){v1[2], v1[3]});
                            v0 = (f32x4){a.x, a.y, b.x, b.y}; v1 = (f32x4){c.x, c.y, d.x, d.y}; }
                        else { v0 = (f32x4){silu_f(v0[0]), silu_f(v0[1]), silu_f(v0[2]), silu_f(v0[3])}; v1 = (f32x4){silu_f(v1[0]), silu_f(v1[1]), silu_f(v1[2]), silu_f(v1[3])}; }
                        *(u32x4*)(rowp + bj * HALF) = pk_h8(v0, v1); } }
        } else if (pn == 8) {
            const int col0 = wc * 32 + 8 * fq;
#pragma unroll
            for (int ai = 0; ai < 2; ++ai)
#pragma unroll
                for (int m = 0; m < 4; ++m) { const int row = row0 + ai * HALF + m * 16; h16* rowp = CQ + (size_t)row * QR + col0; float s = 0.f;
#pragma unroll
                    for (int bj = 0; bj < 2; ++bj) { const f32x4 v0 = acc[ai][bj][m][0], v1 = acc[ai][bj][m][1];
                        s += (v0[0] * v0[0] + v0[1] * v0[1]) + (v0[2] * v0[2] + v0[3] * v0[3]) + (v1[0] * v1[0] + v1[1] * v1[1]) + (v1[2] * v1[2] + v1[3] * v1[3]);
                        *(u32x4*)(rowp + bj * HALF) = pk_h8(v0, v1); }
                    s += __shfl_xor(s, 16); s += __shfl_xor(s, 32);
                    if (fq == 0) atomicAdd(ssq + row, s); }
        } else {
#pragma unroll
            for (int ai = 0; ai < 2; ++ai)
#pragma unroll
                for (int m = 0; m < 4; ++m) { const int row = row0 + ai * HALF + m * 16;
                    { const f32x4 v0 = acc[ai][0][m][0], v1 = acc[ai][0][m][1];
                        float s = (v0[0] * v0[0] + v0[1] * v0[1]) + (v0[2] * v0[2] + v0[3] * v0[3]) + (v1[0] * v1[0] + v1[1] * v1[1]) + (v1[2] * v1[2] + v1[3] * v1[3]);
                        float* p = CKVR + (size_t)row * CKV + wc * 32 + 8 * fq; *(f32x4*)p = v0; *(f32x4*)(p + 4) = v1;
                        s += __shfl_xor(s, 16); s += __shfl_xor(s, 32);
                        if (fq == 0) atomicAdd(sskv + row, s); }
                    const f32x4 x1 = acc[ai][1][m][0], x2 = acc[ai][1][m][1];
                    if (wc == 0) {
                        const int pos = row & (SEQ - 1); const float* rp = rope + (size_t)pos * 32 + 8 * fq;
                        const f32x4 r0 = *(const f32x4*)rp, r1 = *(const f32x4*)(rp + 4);
                        const float o1a = x1[0] * r0[0] - x2[0] * r0[1], o2a = x2[0] * r0[0] + x1[0] * r0[1];
                        const float o1b = x1[1] * r0[2] - x2[1] * r0[3], o2b = x2[1] * r0[2] + x1[1] * r0[3];
                        const float o1c = x1[2] * r1[0] - x2[2] * r1[1], o2c = x2[2] * r1[0] + x1[2] * r1[1];
                        const float o1d = x1[3] * r1[2] - x2[3] * r1[3], o2d = x2[3] * r1[2] + x1[3] * r1[3];
                        h16* p = KV + (size_t)row * KVD + CKV + 4 * fq;
                        typedef unsigned u32x2 __attribute__((ext_vector_type(2)));
                        *(u32x2*)p = (u32x2){pk_h2(o1a, o1b), pk_h2(o1c, o1d)}; *(u32x2*)(p + 16) = (u32x2){pk_h2(o2a, o2b), pk_h2(o2c, o2d)};
                    } else if (wc < 3) {
                        *(u32x4*)(KIDX + (size_t)row * IDXD + (wc - 1) * 32 + 8 * fq) = pk_h8(x1, x2);
                    } else if (fq == 0) {
                        float* p = WIDX + (size_t)row * NH; *(f32x4*)p = x1 * 0.044194173824159216f; *(f32x4*)(p + 4) = x2 * 0.044194173824159216f;
                    } }
        }
    }
};

struct EpiQ {
    h16 *QA, *QIDX; const float* ssq; const float* rope;
    __device__ __forceinline__ void operator()(const f32x4 (&acc)[2][2][4][2], const Unit& u, int wr, int wc, int fr, int fq) const {
        const int row0 = u.pm * BM + wr * 64 + fr, pn = u.pn;
        if (pn < 6) {
            h16* base = pn < 4 ? QA + (2 * pn) * KVD + wc * 32 + 8 * fq : QIDX + (pn - 4) * 256 + wc * 32 + 8 * fq;
            const int rs = pn < 4 ? NH * KVD : 512, bs = pn < 4 ? KVD : HALF;
#pragma unroll
            for (int ai = 0; ai < 2; ++ai)
#pragma unroll
                for (int m = 0; m < 4; ++m) { const int row = row0 + ai * HALF + m * 16; const float rstd = rsqrtf(ssq[row] * (1.f / QR) + EPS);
                    h16* rowp = base + (size_t)row * rs;
#pragma unroll
                    for (int bj = 0; bj < 2; ++bj) *(u32x4*)(rowp + bj * bs) = pk_h8(acc[ai][bj][m][0] * rstd, acc[ai][bj][m][1] * rstd); }
        } else {
#pragma unroll
            for (int ai = 0; ai < 2; ++ai)
#pragma unroll
                for (int m = 0; m < 4; ++m) { const int row = row0 + ai * HALF + m * 16; const float rstd = rsqrtf(ssq[row] * (1.f / QR) + EPS);
                    const int pos = row & (SEQ - 1); const float* rp = rope + (size_t)pos * 32 + 8 * fq;
                    const f32x4 r0 = *(const f32x4*)rp * rstd, r1 = *(const f32x4*)(rp + 4) * rstd;
#pragma unroll
                    for (int bj = 0; bj < 2; ++bj) { const f32x4 v0 = acc[ai][bj][m][0], v1 = acc[ai][bj][m][1];
                        const float o1a = v0[0] * r0[0] - v1[0] * r0[1], o2a = v1[0] * r0[0] + v0[0] * r0[1];
                        const float o1b = v0[1] * r0[2] - v1[1] * r0[3], o2b = v1[1] * r0[2] + v0[1] * r0[3];
                        const float o1c = v0[2] * r1[0] - v1[2] * r1[1], o2c = v1[2] * r1[0] + v0[2] * r1[1];
                        const float o1d = v0[3] * r1[2] - v1[3] * r1[3], o2d = v1[3] * r1[2] + v0[3] * r1[3];
                        h16* p = QA + (size_t)row * (NH * KVD) + (4 * bj + wc) * KVD + CKV + 4 * fq;
                        typedef unsigned u32x2 __attribute__((ext_vector_type(2)));
                        *(u32x2*)p = (u32x2){pk_h2(o1a, o1b), pk_h2(o1c, o1d)}; *(u32x2*)(p + 16) = (u32x2){pk_h2(o2a, o2b), pk_h2(o2c, o2d)}; } }
        }
    }
};
}

constexpr int NTHREADS = 512;
constexpr int LDS_BYTES = 147456;

__global__ __launch_bounds__(NTHREADS, 2) void k_out_gemm(Args a) {
    extern __shared__ __attribute__((aligned(16))) unsigned char lds[];
    unsigned char* ws = a.ws;
    pg8::Gemm g{(const h16*)(ws + WS_A2), (const h16*)(ws + WS_WOUTT), T, DM, DM};
    pg8::StaticOrder S; S.init(T, DM, gridDim.x, blockIdx.x);
    pg8::EpiOut E{(h16*)(ws + WS_Y), (float*)(ws + WS_SSY)};
    pg8::gemm_phase<pg8::EpiOut, true>((PG8_LAS unsigned char*)lds, g, S, E);
}


__global__ __launch_bounds__(NTHREADS, 2) void k_proj_gemm(Args a) {
    extern __shared__ __attribute__((aligned(16))) unsigned char lds[];
    unsigned char* ws = a.ws;
    pg8::Gemm g{(const h16*)(ws + WS_X16), (const h16*)(ws + WS_WINT), T, NP, DM};
    pg8::StaticOrder S; S.init(T, NP, gridDim.x, blockIdx.x);
    pg8::EpiProj E{(h16*)(ws + WS_U), (h16*)(ws + WS_V), (h16*)(ws + WS_ZA), (h16*)(ws + WS_ZB), (h16*)(ws + WS_CQ), (h16*)(ws + WS_KV), (h16*)(ws + WS_KIDX),
                   (float*)(ws + WS_CKVR), (float*)(ws + WS_WIDX), (float*)(ws + WS_SSQ), (float*)(ws + WS_SSKV), (const float*)(ws + WS_ROPE)};
    pg8::gemm_phase<pg8::EpiProj, true>((PG8_LAS unsigned char*)lds, g, S, E);
}


__global__ __launch_bounds__(NTHREADS, 2) void k_q_gemm(Args a) {
    extern __shared__ __attribute__((aligned(16))) unsigned char lds[];
    unsigned char* ws = a.ws;
    pg8::Gemm g{(const h16*)(ws + WS_CQ), (const h16*)(ws + WS_W2T), T, N2, QR};
    pg8::StaticOrder S; S.init(T, N2, gridDim.x, blockIdx.x);
    pg8::EpiQ E{(h16*)(ws + WS_QA), (h16*)(ws + WS_QIDX), (const float*)(ws + WS_SSQ), (const float*)(ws + WS_ROPE)};
    pg8::gemm_phase<pg8::EpiQ, true>((PG8_LAS unsigned char*)lds, g, S, E);
}
__global__ __launch_bounds__(256) void k_ckvnorm(Args a) {
    unsigned char* ws = a.ws; const float* CKVR = (const float*)(ws + WS_CKVR); const float* sskv = (const float*)(ws + WS_SSKV); h16* KV = (h16*)(ws + WS_KV);
    { const h16* KIDX = (const h16*)(ws + WS_KIDX); unsigned* kmax = (unsigned*)(ws + WS_KMAX);
      for (int tok = blockIdx.x * blockDim.x + threadIdx.x; tok < T; tok += gridDim.x * blockDim.x) { float s = 0.f;
        for (int e = 0; e < 8; ++e) { const h16x8 v = *(const h16x8*)(KIDX + (size_t)tok * IDXD + 8 * e); for (int k = 0; k < 8; ++k) s += (float)v[k] * (float)v[k]; }
        for (int o = 1; o < 64; o <<= 1) s = fmaxf(s, __shfl_xor(s, o));
        if ((threadIdx.x & 63) == 0) atomicMax(kmax + tok / SEQ, __float_as_uint(s)); } }
    for (int i = blockIdx.x * blockDim.x + threadIdx.x; i < T * 16; i += gridDim.x * blockDim.x) {
        const int tok = i >> 4, c = (i & 15) * 8; const float rstd = rsqrtf(sskv[tok] * (1.f / CKV) + EPS);
        const f32x4 v0 = *(const f32x4*)(CKVR + (size_t)tok * CKV + c), v1 = *(const f32x4*)(CKVR + (size_t)tok * CKV + c + 4);
        const f32x4 g0 = *(const f32x4*)(a.kvn_g + c), g1 = *(const f32x4*)(a.kvn_g + c + 4);
        *(pg8::u32x4*)(KV + (size_t)tok * KVD + c) = pg8::pk_h8(v0 * rstd * g0, v1 * rstd * g1);
    }
}


namespace p3 {
#define LAS __attribute__((address_space(3)))
typedef float f32x16 __attribute__((ext_vector_type(16)));
typedef short s16x4 __attribute__((ext_vector_type(4)));
typedef unsigned u32x4 __attribute__((ext_vector_type(4)));
typedef unsigned u32x2 __attribute__((ext_vector_type(2)));
constexpr int CC = 96;
constexpr int L_SEL = 0;
constexpr int L_META = 16384;
constexpr int L_WQ = L_META + 1024;
constexpr int L_QN = L_WQ + 1024;
constexpr int L_MISC = L_QN + 1024;
constexpr int L_QS = 20480, QS_STRIDE = 1040;
constexpr int L_HIST = L_QS + 32 * QS_STRIDE;
constexpr int L_CAND = L_HIST + 65536;
constexpr int L_VBUF = 20480;
constexpr int L_OLAT = L_VBUF + 65536, OL_STRIDE = 2064;
constexpr int L_END = L_OLAT + 32 * OL_STRIDE;
static_assert(L_CAND + 32 * CC * 8 <= L_END, "lds map");

__device__ __forceinline__ float med3(float a, float b, float c) { return __builtin_amdgcn_fmed3f(a, b, c); }

constexpr unsigned KBASE = 0x3C000000u >> 7;
constexpr unsigned K1 = (512u << 10) - KBASE, K2 = (512u << 10) - 1u + KBASE;
template <int PASS>
__device__ __forceinline__ void index_pass(LAS unsigned char* lds, const h16* kb, int nslab, int wid, int lane) {
    asm volatile("" : "+v"(lane));
    const int r = lane & 31, hh = lane >> 5;
    float w[8];
    { const f32x4 w0 = *(const LAS f32x4*)(lds + L_WQ + r * 32), w1 = *(const LAS f32x4*)(lds + L_WQ + r * 32 + 16);
      w[0] = w0[0]; w[1] = w0[1]; w[2] = w0[2]; w[3] = w0[3]; w[4] = w1[0]; w[5] = w1[1]; w[6] = w1[2]; w[7] = w1[3]; }
    const float sp = *(const LAS float*)(lds + L_META + r * 4), sn = *(const LAS float*)(lds + L_META + 128 + r * 4);
    unsigned tlo = 0u, thi = 0u;
    if (PASS >= 2) { tlo = *(const LAS unsigned*)(lds + L_META + 256 + r * 4); thi = *(const LAS unsigned*)(lds + L_META + 768 + r * 4); }
    const LAS unsigned char* qbase = lds + L_QS + r * QS_STRIDE + hh * 16;
    LAS unsigned* hist = (LAS unsigned*)(lds + L_HIST + r * 2048);
    LAS unsigned* selcnt = (LAS unsigned*)(lds + L_META + 512 + r * 4);
    LAS unsigned* candcnt = (LAS unsigned*)(lds + L_META + 640 + r * 4);
    LAS unsigned short* sel = (LAS unsigned short*)(lds + L_SEL) + r * 256;
    LAS u32x2* cand = (LAS u32x2*)(lds + L_CAND) + r * CC;
    h16x8 a[4];
    int s = wid;
    if (s < nslab) { const h16* kp = kb + (size_t)(s * 32 + r) * IDXD + hh * 8;
#pragma unroll
        for (int ks = 0; ks < 4; ++ks) a[ks] = *(const h16x8*)(kp + 16 * ks); }
    for (; s < nslab; s += 8) {
        h16x8 an[4];
        { const int sn_ = (s + 8 < nslab) ? s + 8 : s; const h16* kp = kb + (size_t)(sn_ * 32 + r) * IDXD + hh * 8;
#pragma unroll
          for (int ks = 0; ks < 4; ++ks) an[ks] = *(const h16x8*)(kp + 16 * ks); }
        f32x16 score;
#pragma unroll
        for (int i = 0; i < 16; ++i) score[i] = 0.f;
#pragma unroll
        for (int h = 0; h < 8; ++h) {
            f32x16 acc;
#pragma unroll
            for (int i = 0; i < 16; ++i) acc[i] = 0.f;
#pragma unroll
            for (int ks = 0; ks < 4; ++ks) acc = __builtin_amdgcn_mfma_f32_32x32x16_f16(a[ks], *(const LAS h16x8*)(qbase + h * 128 + ks * 32), acc, 0, 0, 0);
#pragma unroll
            for (int i = 0; i < 16; ++i) score[i] = __builtin_fmaf(w[h], __builtin_fmaxf(acc[i], 0.f), score[i]);
        }
#pragma unroll
        for (int i = 0; i < 16; ++i) {
            const float sc = score[i]; const bool pos = sc >= 0.f;
            const float v = __builtin_fminf(__builtin_fmaf(__builtin_fabsf(sc), pos ? sp : sn, 0.0078125f), 1.99f);
            const unsigned x = __float_as_uint(v) >> 7;
            const unsigned ck = pos ? x + K1 : K2 - x;
            if (PASS == 1) { const unsigned bin = ck >> 10; __hip_atomic_fetch_add(hist + (bin >> 1), 1u << ((bin & 1u) * 16u), __ATOMIC_RELAXED, __HIP_MEMORY_SCOPE_WORKGROUP); }
            else if (PASS == 2) { if ((ck >> 10) == tlo) { const unsigned sub = ck & 1023u; __hip_atomic_fetch_add(hist + (sub >> 1), 1u << ((sub & 1u) * 16u), __ATOMIC_RELAXED, __HIP_MEMORY_SCOPE_WORKGROUP); } }
            else if (ck >= tlo) {
                const unsigned key = (unsigned)(s * 32 + (i & 3) + 8 * (i >> 2) + 4 * hh);
                if (ck >= thi) { const unsigned p = __hip_atomic_fetch_add(selcnt, 1u, __ATOMIC_RELAXED, __HIP_MEMORY_SCOPE_WORKGROUP); if (p < 256u) sel[p] = (unsigned short)key; }
                else { const unsigned p = __hip_atomic_fetch_add(candcnt, 1u, __ATOMIC_RELAXED, __HIP_MEMORY_SCOPE_WORKGROUP); if (p < (unsigned)CC) cand[p] = (u32x2){__float_as_uint(sc), key}; }
            }
        }
#pragma unroll
        for (int ks = 0; ks < 4; ++ks) a[ks] = an[ks];
    }
}

__device__ __forceinline__ void find_thr(LAS unsigned char* lds, int q, unsigned need, int lane, int& tbin, unsigned& nabove, unsigned& nin) {
    const LAS u32x4* hq = (const LAS u32x4*)(lds + L_HIST + q * 2048 + lane * 32); const u32x4 wa = hq[0], wb = hq[1];
    unsigned wv[8] = {wa[0], wa[1], wa[2], wa[3], wb[0], wb[1], wb[2], wb[3]}; unsigned tot = 0;
#pragma unroll
    for (int e = 0; e < 8; ++e) tot += (wv[e] & 0xffffu) + (wv[e] >> 16);
    unsigned sfx = tot;
#pragma unroll
    for (int o = 1; o < 64; o <<= 1) { const unsigned t = __shfl_down(sfx, o); if (lane + o < 64) sfx += t; }
    const unsigned long long bal = __ballot(sfx >= need);
    const int L = bal ? 63 - __builtin_clzll(bal) : 0;
    unsigned above = sfx - tot, nab = above, ni = 0; bool found = false; int tb = 16 * lane;
#pragma unroll
    for (int e = 7; e >= 0; --e) { const unsigned c1 = wv[e] >> 16, c0 = wv[e] & 0xffffu;
        if (!found && above + c1 >= need) { found = true; tb = 16 * lane + 2 * e + 1; nab = above; ni = c1; }
        if (!found) above += c1;
        if (!found && above + c0 >= need) { found = true; tb = 16 * lane + 2 * e; nab = above; ni = c0; }
        if (!found) above += c0; }
    tbin = __shfl(tb, L); nabove = __shfl(nab, L); nin = __shfl(ni, L);
}

__device__ __forceinline__ void attn_query(LAS unsigned char* lds, const h16* qa, const h16* kvb, int qi, int cnt, int wid, int lane) {
    asm volatile("" : "+v"(lane));
    const int c15 = lane & 15, g = lane >> 4, k7 = c15 & 7;
    h16x8 qb[5];
#pragma unroll
    for (int ks = 0; ks < 5; ++ks) { h16x8 z; for (int e = 0; e < 8; ++e) z[e] = (h16)0.f; qb[ks] = c15 < 8 ? *(const h16x8*)(qa + c15 * KVD + 32 * ks + 8 * g) : z; }
    f32x4 o[8];
#pragma unroll
    for (int ct = 0; ct < 8; ++ct) o[ct] = (f32x4){0.f, 0.f, 0.f, 0.f};
    float m_run = -INFINITY, l_part = 0.f;
    const LAS unsigned short* sel = (const LAS unsigned short*)(lds + L_SEL) + qi * 256;
    LAS unsigned char* vb = lds + L_VBUF + wid * 8192;
    LAS unsigned char* wrow = vb + c15 * 256;
    const int kt = 4 * g + (c15 >> 2), pp = c15 & 3;
    const unsigned trbase = (unsigned)(uintptr_t)(vb + kt * 256 + 16 * (pp >> 1) + 8 * (pp & 1));
    const int kt7 = kt & 7;
    const int nch = cnt >> 5;
    constexpr float SC = 0.10206207261596577f * 1.4426950408889634f;
    for (int c = 0; c < nch; ++c) {
        const int i0 = sel[32 * c + c15], i1 = sel[32 * c + 16 + c15];
        const h16* r0 = kvb + (size_t)i0 * KVD + 8 * g; const h16* r1 = kvb + (size_t)i1 * KVD + 8 * g;
        h16x8 a0[5], a1[5];
#pragma unroll
        for (int ks = 0; ks < 5; ++ks) { a0[ks] = *(const h16x8*)(r0 + 32 * ks); a1[ks] = *(const h16x8*)(r1 + 32 * ks); }
#pragma unroll
        for (int ks = 0; ks < 4; ++ks) { const int ch = ((4 * ks + g) ^ (2 * k7)) << 4; *(LAS h16x8*)(wrow + ch) = a0[ks]; *(LAS h16x8*)(wrow + 4096 + ch) = a1[ks]; }
        f32x4 s0 = (f32x4){0.f, 0.f, 0.f, 0.f}, s1 = (f32x4){0.f, 0.f, 0.f, 0.f};
#pragma unroll
        for (int ks = 0; ks < 5; ++ks) { s0 = __builtin_amdgcn_mfma_f32_16x16x32_f16(a0[ks], qb[ks], s0, 0, 0, 0); s1 = __builtin_amdgcn_mfma_f32_16x16x32_f16(a1[ks], qb[ks], s1, 0, 0, 0); }
        s0 = s0 * SC; s1 = s1 * SC;
        float mx = fmaxf(fmaxf(fmaxf(s0[0], s0[1]), fmaxf(s0[2], s0[3])), fmaxf(fmaxf(s1[0], s1[1]), fmaxf(s1[2], s1[3])));
        mx = fmaxf(mx, __shfl_xor(mx, 16)); mx = fmaxf(mx, __shfl_xor(mx, 32));
        const float mn = fmaxf(m_run, mx), alpha = __builtin_amdgcn_exp2f(m_run - mn);
        f32x4 p0, p1;
#pragma unroll
        for (int e = 0; e < 4; ++e) { p0[e] = __builtin_amdgcn_exp2f(s0[e] - mn); p1[e] = __builtin_amdgcn_exp2f(s1[e] - mn); }
        l_part = l_part * alpha + ((p0[0] + p0[1]) + (p0[2] + p0[3])) + ((p1[0] + p1[1]) + (p1[2] + p1[3]));
        m_run = mn;
#pragma unroll
        for (int ct = 0; ct < 8; ++ct) o[ct] = o[ct] * alpha;
        h16x8 pb; pb[0] = (h16)p0[0]; pb[1] = (h16)p0[1]; pb[2] = (h16)p0[2]; pb[3] = (h16)p0[3]; pb[4] = (h16)p1[0]; pb[5] = (h16)p1[1]; pb[6] = (h16)p1[2]; pb[7] = (h16)p1[3];
        s16x4 lo[8], hi[8];
#pragma unroll
        for (int ct = 0; ct < 8; ++ct) { const unsigned ad = trbase + (unsigned)((ct ^ kt7) << 5);
            asm volatile("ds_read_b64_tr_b16 %0, %1" : "=&v"(lo[ct]) : "v"(ad) : "memory");
            asm volatile("ds_read_b64_tr_b16 %0, %1 offset:4096" : "=&v"(hi[ct]) : "v"(ad) : "memory"); }
        asm volatile("s_waitcnt lgkmcnt(0)" ::: "memory"); __builtin_amdgcn_sched_barrier(0);
#pragma unroll
        for (int ct = 0; ct < 8; ++ct) { const s16x4 l4 = lo[ct], h4 = hi[ct];
            typedef short s16x8 __attribute__((ext_vector_type(8)));
            const s16x8 va = (s16x8){l4[0], l4[1], l4[2], l4[3], h4[0], h4[1], h4[2], h4[3]};
            o[ct] = __builtin_amdgcn_mfma_f32_16x16x32_f16(__builtin_bit_cast(h16x8, va), pb, o[ct], 0, 0, 0); }
    }
    float l = l_part; l += __shfl_xor(l, 16); l += __shfl_xor(l, 32);
    const float inv = 1.0f / l;
    if (c15 < 8) {
        LAS unsigned char* op = lds + L_OLAT + qi * OL_STRIDE + c15 * 256 + 8 * g;
#pragma unroll
        for (int ct = 0; ct < 8; ++ct) { h16x4 v; v[0] = (h16)(o[ct][0] * inv); v[1] = (h16)(o[ct][1] * inv); v[2] = (h16)(o[ct][2] * inv); v[3] = (h16)(o[ct][3] * inv);
            *(LAS h16x4*)(op + 32 * ct) = v; }
    }
}

__device__ __forceinline__ void phase(LAS unsigned char* lds, unsigned char* ws) {
    const int tid = threadIdx.x, wid = __builtin_amdgcn_readfirstlane(tid >> 6), lane = tid & 63;
    const h16* QIDX = (const h16*)(ws + WS_QIDX); const h16* KIDX = (const h16*)(ws + WS_KIDX); const float* WIDX = (const float*)(ws + WS_WIDX);
    const h16* QA = (const h16*)(ws + WS_QA); const h16* KV = (const h16*)(ws + WS_KV); const h16* WuvT = (const h16*)(ws + WS_WUVT);
    const h16* ZB = (const h16*)(ws + WS_ZB); h16* A2 = (h16*)(ws + WS_A2);
    unsigned* qctr = (unsigned*)(ws + WS_QUEUE); const unsigned* kmaxp = (const unsigned*)(ws + WS_KMAX);
    const int queue = blockIdx.x & 7, b = queue >> 1;
    LAS int* misc = (LAS int*)(lds + L_MISC);
    for (;;) {
        if (tid == 0) misc[0] = (int)atomicAdd(qctr + queue * 64, 1u);
        __syncthreads();
        const int j = misc[0];
        if (j >= 128) break;
        const int qt = 255 - 2 * j - (queue & 1), q0 = qt * 32, tok0 = b * SEQ + q0, N = ((q0 >> 6) + 1) * 64;
        for (int i = tid; i < 1024; i += NTHREADS) ((LAS u32x4*)(lds + L_SEL))[i] = (u32x4){0u, 0u, 0u, 0u};
        if (N <= TOPK) {
            __syncthreads();
            for (int i = tid; i < 32 * 256; i += NTHREADS) { const int jj = i & 255; if (jj < N) ((LAS unsigned short*)(lds + L_SEL))[i] = (unsigned short)jj; }
        } else {
            { const int q = tid >> 4, part = tid & 15; const h16* src = QIDX + (size_t)(tok0 + q) * 512 + part * 32; LAS unsigned char* dst = lds + L_QS + q * QS_STRIDE + part * 64;
#pragma unroll
              for (int e = 0; e < 4; ++e) *(LAS h16x8*)(dst + 16 * e) = *(const h16x8*)(src + 8 * e); }
            if (tid < 256) ((LAS float*)(lds + L_WQ))[tid] = WIDX[(size_t)tok0 * 8 + tid];
#pragma unroll
            for (int e = 0; e < 8; ++e) ((LAS u32x4*)(lds + L_HIST))[tid + e * NTHREADS] = (u32x4){0u, 0u, 0u, 0u};
            if (tid < 64) ((LAS unsigned*)(lds + L_META + 512))[tid] = 0u;
            __syncthreads();
            if (tid < 256) { const int q = tid >> 3, h = tid & 7; const LAS unsigned char* p = lds + L_QS + q * QS_STRIDE + h * 128; float s = 0.f;
#pragma unroll
                for (int e = 0; e < 8; ++e) { const h16x8 v = *(const LAS h16x8*)(p + 16 * e);
#pragma unroll
                    for (int k = 0; k < 8; ++k) s += (float)v[k] * (float)v[k]; }
                ((LAS float*)(lds + L_QN))[tid] = sqrtf(s); }
            __syncthreads();
            if (tid < 32) { const float kmax = sqrtf(__uint_as_float(kmaxp[b])); float bp = 0.f, bn = 0.f;
#pragma unroll
                for (int h = 0; h < 8; ++h) { const float wv = ((const LAS float*)(lds + L_WQ))[tid * 8 + h], t = fabsf(wv) * ((const LAS float*)(lds + L_QN))[tid * 8 + h] * kmax; if (wv > 0.f) bp += t; else bn += t; }
                ((LAS float*)(lds + L_META))[tid] = bp > 0.f ? 1.0f / (bp * 1.0005f) : 0.f; ((LAS float*)(lds + L_META + 128))[tid] = bn > 0.f ? 1.0f / (bn * 1.0005f) : 0.f; }
            if (tid == 0) misc[1] = 0;
            __syncthreads();
            const h16* kb = KIDX + (size_t)b * SEQ * IDXD; const int nslab = N >> 5;
            index_pass<1>(lds, kb, nslab, wid, lane);
            __syncthreads();
            for (int i = 0; i < 4; ++i) { const int q = wid * 4 + i; int tbin; unsigned nab, nin;
                find_thr(lds, q, (unsigned)TOPK, lane, tbin, nab, nin);
                if (lane == 0) { const bool fl = nin > (unsigned)CC;
                    ((LAS unsigned*)(lds + L_META + 256))[q] = fl ? (unsigned)tbin : ((unsigned)tbin << 10);
                    ((LAS unsigned*)(lds + L_META + 768))[q] = fl ? 1u : (((unsigned)tbin + 1u) << 10);
                    ((LAS int*)(lds + L_META + 384))[q] = (int)nab;
                    if (fl) misc[1] = 1; } }
            __syncthreads();
            if (misc[1] != 0) {
#pragma unroll
                for (int e = 0; e < 8; ++e) ((LAS u32x4*)(lds + L_HIST))[tid + e * NTHREADS] = (u32x4){0u, 0u, 0u, 0u};
                unsigned myflag = 0, mytb = 0;
                if (tid < 32) { myflag = ((const LAS unsigned*)(lds + L_META + 768))[tid] == 1u; mytb = ((const LAS unsigned*)(lds + L_META + 256))[tid]; }
                __syncthreads();
                if (tid < 32 && !myflag) ((LAS unsigned*)(lds + L_META + 256))[tid] = 0xffffffffu;
                __syncthreads();
                index_pass<2>(lds, kb, nslab, wid, lane);
                __syncthreads();
                if (tid < 32 && !myflag) ((LAS unsigned*)(lds + L_META + 256))[tid] = mytb;
                for (int i = 0; i < 4; ++i) { const int q = wid * 4 + i;
                    const bool fl = ((const LAS unsigned*)(lds + L_META + 768))[q] == 1u;
                    if (fl) { const unsigned tb1 = ((const LAS unsigned*)(lds + L_META + 256))[q]; const int nab1 = ((const LAS int*)(lds + L_META + 384))[q];
                        int tsub; unsigned nab2, nin2; find_thr(lds, q, (unsigned)(TOPK - nab1), lane, tsub, nab2, nin2);
                        if (lane == 0) { const unsigned tl = (tb1 << 10) | (unsigned)tsub;
                            ((LAS unsigned*)(lds + L_META + 256))[q] = tl; ((LAS unsigned*)(lds + L_META + 768))[q] = tl + 1u; ((LAS int*)(lds + L_META + 384))[q] = nab1 + (int)nab2; } } }
                __syncthreads();
            }
            index_pass<3>(lds, kb, nslab, wid, lane);
            __syncthreads();
            for (int i = 0; i < 4; ++i) { const int q = wid * 4 + i;
                const unsigned mc = ((const LAS unsigned*)(lds + L_META + 640))[q]; const int m = mc < (unsigned)CC ? (int)mc : CC;
                const int nab = ((const LAS int*)(lds + L_META + 384))[q], need = TOPK - nab;
                const LAS u32x2* cd = (const LAS u32x2*)(lds + L_CAND) + q * CC;
                for (int c = lane; c < m; c += 64) { const u32x2 me = cd[c]; const float sc = __uint_as_float(me[0]); int rank = 0;
                    for (int k = 0; k < m; ++k) { const u32x2 ot = cd[k]; const float so = __uint_as_float(ot[0]); rank += (so > sc || (so == sc && ot[1] < me[1])) ? 1 : 0; }
                    if (rank < need) ((LAS unsigned short*)(lds + L_SEL))[q * 256 + nab + rank] = (unsigned short)me[1]; } }
        }
        __syncthreads();
        const int cnt = N < TOPK ? N : TOPK;
        for (int i = 0; i < 4; ++i) { const int qi = wid * 4 + i; attn_query(lds, QA + (size_t)(tok0 + qi) * (NH * KVD), KV + (size_t)b * SEQ * KVD, qi, cnt, wid, lane); }
        __syncthreads();
        {
            int lane2 = lane; asm volatile("" : "+v"(lane2));
            const int r = lane2 & 31, hh = lane2 >> 5;
            f32x16 acc0, acc1;
#pragma unroll
            for (int i = 0; i < 16; ++i) { acc0[i] = 0.f; acc1[i] = 0.f; }
            const h16* wu = WuvT + (size_t)(wid * 64 + r) * 128 + 8 * hh;
            const LAS unsigned char* ap = lds + L_OLAT + r * OL_STRIDE + wid * 256 + 16 * hh;
#pragma unroll
            for (int ks = 0; ks < 8; ++ks) { const h16x8 af = *(const LAS h16x8*)(ap + 32 * ks); const h16x8 b0 = *(const h16x8*)(wu + 16 * ks), b1 = *(const h16x8*)(wu + 32 * 128 + 16 * ks);
                acc0 = __builtin_amdgcn_mfma_f32_32x32x16_f16(af, b0, acc0, 0, 0, 0); acc1 = __builtin_amdgcn_mfma_f32_32x32x16_f16(af, b1, acc1, 0, 0, 0); }
#pragma unroll
            for (int i = 0; i < 16; ++i) { const int q = (i & 3) + 8 * (i >> 2) + 4 * hh; const size_t tok = (size_t)(tok0 + q); const int col = wid * 64 + r;
                const float g0 = (float)ZB[tok * GW + col], g1 = (float)ZB[tok * GW + col + 32];
                A2[tok * DM + 512 + col] = (h16)(acc0[i] * g0); A2[tok * DM + 512 + col + 32] = (h16)(acc1[i] * g1); }
        }
        __syncthreads();
    }
}
}

constexpr int LDS3_BYTES = 153600;
__global__ __launch_bounds__(NTHREADS, 2) void k_index_attn(Args a) {
    extern __shared__ __attribute__((aligned(16))) unsigned char lds[];
    p3::phase((LAS unsigned char*)lds, a.ws);
}

__global__ __launch_bounds__(256) void naive_out(Args a) {
    __shared__ float as_[8][1024];
    __shared__ float red[8][4];
    unsigned char* ws = a.ws;
    const h16* A2 = (const h16*)(ws + WS_A2); const h16* WoutT = (const h16*)(ws + WS_WOUTT); h16* Y = (h16*)(ws + WS_Y); float* ssy = (float*)(ws + WS_SSY);
    const int tid = threadIdx.x, row0 = blockIdx.x * 8;
    for (int i = tid; i < 8 * 1024; i += 256) as_[i >> 10][i & 1023] = (float)A2[(size_t)(row0 + (i >> 10)) * DM + (i & 1023)];
    __syncthreads();
    float sq[8] = {0.f, 0.f, 0.f, 0.f, 0.f, 0.f, 0.f, 0.f};
    for (int n = tid; n < DM; n += 256) {
        float acc[8] = {0.f, 0.f, 0.f, 0.f, 0.f, 0.f, 0.f, 0.f};
        const h16* w = WoutT + (size_t)n * DM;
        for (int k = 0; k < DM; k += 8) { const h16x8 wv = *(const h16x8*)(w + k);
#pragma unroll
            for (int j = 0; j < 8; ++j) { const float wf = (float)wv[j];
#pragma unroll
                for (int r = 0; r < 8; ++r) acc[r] += as_[r][k + j] * wf; } }
#pragma unroll
        for (int r = 0; r < 8; ++r) { Y[(size_t)(row0 + r) * DM + n] = (h16)acc[r]; sq[r] += acc[r] * acc[r]; }
    }
#pragma unroll
    for (int r = 0; r < 8; ++r) { float t = sq[r];
#pragma unroll
        for (int o = 1; o < 64; o <<= 1) t += __shfl_xor(t, o);
        if ((tid & 63) == 0) red[r][tid >> 6] = t; }
    __syncthreads();
    if (tid < 8) ssy[row0 + tid] = (red[tid][0] + red[tid][1]) + (red[tid][2] + red[tid][3]);
}

__global__ __launch_bounds__(256) void final_out(Args a) {
    const h16* Y = (const h16*)(a.ws + WS_Y); const float* ssy = (const float*)(a.ws + WS_SSY);
    const size_t n4 = (size_t)T * DM / 4;
    for (size_t i = (size_t)blockIdx.x * blockDim.x + threadIdx.x; i < n4; i += (size_t)gridDim.x * blockDim.x) {
        const int row = (int)(i >> 8), c4 = (int)(i & 255);
        const float rstd = rsqrtf(ssy[row] * (1.f / DM) + EPS);
        const f32x4 xv = *((const f32x4*)a.x + i); const f32x4 g = *((const f32x4*)a.post_g + c4); const h16x4 yv = *((const h16x4*)Y + i);
        f32x4 o; o.x = xv.x + (float)yv.x * rstd * g.x; o.y = xv.y + (float)yv.y * rstd * g.y; o.z = xv.z + (float)yv.z * rstd * g.z; o.w = xv.w + (float)yv.w * rstd * g.w;
        *((f32x4*)a.out + i) = o;
    }
}

extern "C" void kernel_launch(void* const* d_in, const int* in_sizes, int n_in, void* d_out, int out_size, void* d_ws, size_t ws_size, hipStream_t stream) {
    if (n_in != 15 || ws_size < WS_END) { fprintf(stderr, "kernel_launch: unexpected n_in %d / ws %zu\n", n_in, ws_size); return; }
    Args a{};
    a.x = (const float*)d_in[0]; a.w_in = (const float*)d_in[1]; a.pre_g = (const float*)d_in[2]; a.post_g = (const float*)d_in[3];
    a.ln_g = (const float*)d_in[4]; a.ln_b = (const float*)d_in[5]; a.w_s = (const float*)d_in[6]; a.b_s = (const float*)d_in[7];
    a.qn_g = (const float*)d_in[8]; a.kvn_g = (const float*)d_in[9]; a.w_uq = (const float*)d_in[10]; a.w_uk = (const float*)d_in[11];
    a.w_uv = (const float*)d_in[12]; a.w_qidx = (const float*)d_in[13]; a.w_out = (const float*)d_in[14];
    a.out = (float*)d_out; a.ws = (unsigned char*)d_ws;
    static bool attr_done = false;
    if (!attr_done) { if (hipFuncSetAttribute((const void*)k_out_gemm, hipFuncAttributeMaxDynamicSharedMemorySize, LDS_BYTES) != hipSuccess) fprintf(stderr, "hipFuncSetAttribute failed\n"); (void)hipFuncSetAttribute((const void*)k_proj_gemm, hipFuncAttributeMaxDynamicSharedMemorySize, LDS_BYTES); (void)hipFuncSetAttribute((const void*)k_q_gemm, hipFuncAttributeMaxDynamicSharedMemorySize, LDS_BYTES); (void)hipFuncSetAttribute((const void*)k_index_attn, hipFuncAttributeMaxDynamicSharedMemorySize, LDS3_BYTES); attr_done = true; }
    (void)hipMemsetAsync((char*)d_ws + WS_CTL, 0, 1 * MiB, stream);
    hipLaunchKernelGGL(prep_weights, dim3(1024), dim3(256), 0, stream, a);
    hipLaunchKernelGGL(prep_x, dim3(2048), dim3(256), 0, stream, a);
    hipLaunchKernelGGL(k_proj_gemm, dim3(256), dim3(NTHREADS), LDS_BYTES, stream, a);
    hipLaunchKernelGGL(k_q_gemm, dim3(256), dim3(NTHREADS), LDS_BYTES, stream, a);
    hipLaunchKernelGGL(k_ckvnorm, dim3(1024), dim3(256), 0, stream, a);
    hipLaunchKernelGGL(naive_gmlp, dim3(T / 128 * 4), dim3(256), 0, stream, a);
    hipLaunchKernelGGL(k_index_attn, dim3(256), dim3(NTHREADS), LDS3_BYTES, stream, a);
    hipLaunchKernelGGL(k_out_gemm, dim3(256), dim3(NTHREADS), LDS_BYTES, stream, a);
    hipLaunchKernelGGL(final_out, dim3(4096), dim3(256), 0, stream, a);
}
```

```cpp
#include <hip/hip_runtime.h>
#include <cstdio>
#include <cstdint>

typedef _Float16 h16;
typedef _Float16 h16x8 __attribute__((ext_vector_type(8)));
typedef _Float16 h16x4 __attribute__((ext_vector_type(4)));
typedef float f32x4 __attribute__((ext_vector_type(4)));

constexpr int BATCH = 4, SEQ = 8192, T = BATCH * SEQ, DM = 1024;
constexpr int NIN = 2536, NP = 2560;
constexpr int GW = 512;
constexpr int QR = 256, CKV = 128, ROPE = 32, IDXD = 64, NH = 8;
constexpr int KVD = CKV + ROPE;
constexpr int N2 = 1792;
constexpr int TOPK = 256;
constexpr float EPS = 1e-6f;
constexpr int C_U = 0, C_V = 512, C_ZA = 1024, C_ZB = 1536, C_CQ = 2048, C_CKV = 2304, C_KR = 2432, C_KI = 2464, C_WI = 2528;
__host__ __device__ inline int old_col(int n) {
    if (n < 1536) return n;
    if (n < 2048) return 2024 + (n - 1536);
    if (n < 2304) return 1536 + (n - 2048);
    if (n < 2432) return 1792 + (n - 2304);
    if (n < 2464) { const int rho = n - 2432; return 1920 + 16 * ((rho >> 2) & 1) + 4 * (rho >> 3) + (rho & 3); }
    if (n < 2528) return 1952 + (n - 2464);
    if (n < 2536) return 2016 + (n - 2528);
    return -1;
}

constexpr size_t MiB = 1u << 20;
constexpr size_t WS_CTL = 0;
constexpr size_t WS_SSQ = 64 * 1024;
constexpr size_t WS_SSKV = WS_SSQ + T * 4;
constexpr size_t WS_SSY = WS_SSKV + T * 4;
constexpr size_t WS_KMAX = WS_SSY + T * 4;
constexpr size_t WS_QUEUE = 4096;
constexpr size_t WS_WINT = 1 * MiB;
constexpr size_t WS_W2T = 6 * MiB;
constexpr size_t WS_WOUTT = 7 * MiB;
constexpr size_t WS_WUVT = 9 * MiB;
constexpr size_t WS_WSH = 9 * MiB + 256 * 1024;
constexpr size_t WS_ROPE = 10 * MiB;
constexpr size_t WS_WIDX = 11 * MiB;
constexpr size_t WS_CNT = 12 * MiB;
constexpr size_t WS_KIDX = 13 * MiB;
constexpr size_t WS_KV = 17 * MiB;
constexpr size_t WS_CQ = 27 * MiB;
constexpr size_t WS_CKVR = 43 * MiB;
constexpr size_t WS_SEL = 59 * MiB;
constexpr size_t WS_X16 = 75 * MiB;
constexpr size_t WS_Y = WS_X16;
constexpr size_t WS_U = 139 * MiB;
constexpr size_t WS_V = 171 * MiB;
constexpr size_t WS_ZA = 203 * MiB;
constexpr size_t WS_ZB = 235 * MiB;
constexpr size_t WS_QIDX = 267 * MiB;
constexpr size_t WS_QA = 299 * MiB;
constexpr size_t WS_A2 = 379 * MiB;
constexpr size_t WS_END = 443 * MiB;

struct Args {
    const float* x; const float* w_in; const float* pre_g; const float* post_g; const float* ln_g; const float* ln_b;
    const float* w_s; const float* b_s; const float* qn_g; const float* kvn_g; const float* w_uq; const float* w_uk;
    const float* w_uv; const float* w_qidx; const float* w_out;
    float* out; unsigned char* ws;
};

__device__ __forceinline__ float gelu_erf(float v) { return 0.5f * v * (1.0f + erff(v * 0.70710678118654752f)); }
__device__ __forceinline__ float silu(float v) { return v / (1.0f + __expf(-v)); }

__device__ __forceinline__ void prep_weights(const Args& a) {
    int tid_ = threadIdx.x; asm volatile("" : "+v"(tid_));
    const int gtid = blockIdx.x * blockDim.x + tid_, gsz = gridDim.x * blockDim.x;
    unsigned char* ws = a.ws;
    h16* WinT = (h16*)(ws + WS_WINT);
    for (int i = gtid; i < NP * DM; i += gsz) {
        const int k = i / NP, n = i % NP, oc = old_col(n);
        WinT[(size_t)n * DM + k] = (h16)(oc >= 0 ? a.w_in[(size_t)k * NIN + oc] : 0.f);
    }
    h16* W2T = (h16*)(ws + WS_W2T);
    for (int i = gtid; i < N2 * QR; i += gsz) {
        const int k = i / N2, n = i % N2; float v;
        if (n < 1024) { const int h = n >> 7, c = n & 127; float s = 0.f;
            for (int d = 0; d < 64; ++d) s += a.w_uq[(size_t)k * 768 + h * 96 + d] * a.w_uk[(size_t)c * 512 + h * 64 + d];
            v = s;
        } else if (n < 1536) { v = a.w_qidx[(size_t)k * 512 + (n - 1024)]; }
        else { const int j = n - 1536, h = j >> 5, rho = j & 31, r = 16 * ((rho >> 2) & 1) + 4 * (rho >> 3) + (rho & 3); v = a.w_uq[(size_t)k * 768 + h * 96 + 64 + r]; }
        W2T[(size_t)n * QR + k] = (h16)(v * a.qn_g[k]);
    }
    h16* WoutT = (h16*)(ws + WS_WOUTT);
    for (int i = gtid; i < DM * DM; i += gsz) { const int k = i / DM, n = i % DM; WoutT[(size_t)n * DM + k] = (h16)a.w_out[i]; }
    h16* WuvT = (h16*)(ws + WS_WUVT);
    for (int i = gtid; i < 128 * 512; i += gsz) { const int c = i / 512, hd = i % 512, h = hd >> 6, d = hd & 63; WuvT[(size_t)(h * 64 + d) * 128 + c] = (h16)a.w_uv[i]; }
    h16* WsH = (h16*)(ws + WS_WSH);
    for (int i = gtid; i < 4 * 128 * 128; i += gsz) { const int t = (i >> 7) & 127, s = i & 127; WsH[i] = (h16)(((s >> 6) <= (t >> 6)) ? a.w_s[i] : 0.f); }
    float2* rope = (float2*)(ws + WS_ROPE);
    for (int i = gtid; i < SEQ * 16; i += gsz) {
        const int pos = i >> 4, j = i & 15;
        const double invf = exp2(-(double)j * (13.287712379549449 / 16.0));
        const double ang = (double)pos * invf;
        const double n = rint(ang * 0.15915494309189535);
        const float r = (float)(ang - n * 6.283185307179586);
        rope[i] = make_float2(cosf(r), sinf(r));
    }
}

__device__ __forceinline__ void prep_x(const Args& a) {
    int tid_ = threadIdx.x; asm volatile("" : "+v"(tid_));
    const int lane = tid_ & 63, gw = (blockIdx.x * blockDim.x + tid_) >> 6, ngw = (gridDim.x * blockDim.x) >> 6;
    h16* X16 = (h16*)(a.ws + WS_X16);
    for (int row = gw; row < T; row += ngw) {
        const f32x4* xr = (const f32x4*)(a.x + (size_t)row * DM) + lane;
        f32x4 v[4]; float s = 0.f;
#pragma unroll
        for (int j = 0; j < 4; ++j) { v[j] = xr[64 * j]; s += (v[j].x * v[j].x + v[j].y * v[j].y) + (v[j].z * v[j].z + v[j].w * v[j].w); }
#pragma unroll
        for (int o = 1; o < 64; o <<= 1) s += __shfl_xor(s, o);
        const float rstd = rsqrtf(s * (1.f / DM) + EPS);
#pragma unroll
        for (int j = 0; j < 4; ++j) {
            const f32x4 g = *((const f32x4*)a.pre_g + lane + 64 * j);
            h16x4 o; o.x = (h16)(v[j].x * rstd * g.x); o.y = (h16)(v[j].y * rstd * g.y); o.z = (h16)(v[j].z * rstd * g.z); o.w = (h16)(v[j].w * rstd * g.w);
            *((h16x4*)(X16 + (size_t)row * DM) + lane + 64 * j) = o;
        }
    }
}

namespace pg8 {
#define PG8_LAS __attribute__((address_space(3)))
typedef unsigned u32x4 __attribute__((ext_vector_type(4)));
typedef float f32x2 __attribute__((ext_vector_type(2)));
constexpr int BM = 256, BK = 64, HALF = 128, HTB = HALF * BK * 2, STAGE_BYTES = 8 * HTB, NXCD = 8, WGM = 8;
__host__ __device__ __forceinline__ int lds_byte(int r, int c) { const int st = (r >> 4) * 2 + (c >> 5), rr = r & 15, cc = c & 31, ob = rr * 64 + cc * 2; return st * 1024 + (ob ^ (((ob >> 9) & 1) << 5)); }
__host__ __device__ __forceinline__ void stage_rc(int b, int& R, int& C) { const int st = b / 1024, sb = b % 1024, swz = sb ^ (((sb >> 9) & 1) << 5); R = (st >> 1) * 16 + swz / 64; C = (st & 1) * 32 + (swz % 64) / 2; }
__host__ __device__ __forceinline__ int perm32(int rho) { const int n = rho >> 4, i = rho & 15; return 8 * (i >> 2) + 4 * n + (i & 3); }
struct Unit { int pm, pn; };
struct Gemm { const h16* A; const h16* Bt; int M, N, K; };
struct StaticOrder {
    int nM, nN, nwg, G, c;
    __host__ __device__ void init(int M, int N, int G_, int c_) { nM = M / BM; nN = N / BM; nwg = nM * nN; G = G_; c = c_; }
    __host__ __device__ bool next(int i, Unit& u) const {
        const long L = (long)i * G + c; if (L >= nwg) return false;
        int wgid = (int)L; { const int q = nwg / NXCD, r = nwg % NXCD, xcd = wgid % NXCD, off = wgid / NXCD; wgid = (xcd < r ? xcd * (q + 1) : r * (q + 1) + (xcd - r) * q) + off; }
        const int nig = WGM * nN, gid = wgid / nig, fm = gid * WGM, gsz = (nM - fm) < WGM ? (nM - fm) : WGM;
        u.pm = fm + ((wgid % nig) % gsz); u.pn = (wgid % nig) / gsz; return true;
    }
};
__device__ __forceinline__ f32x2 gelu_pk(f32x2 v) {
    const f32x2 av = __builtin_elementwise_abs(v), d = av * 0.2316418882f + 1.0f;
    f32x2 t; t.x = __builtin_amdgcn_rcpf(d.x); t.y = __builtin_amdgcn_rcpf(d.y);
    f32x2 q = t * 0.5307027145f + (-0.7265760135f); q = q * t + 0.7107068705f; q = q * t + (-0.142248368f); q = q * t + 0.127414796f; q = q * t;
    const f32x2 s = (v * v) * (-0.72134752044f);
    f32x2 e; e.x = __builtin_amdgcn_exp2f(s.x); e.y = __builtin_amdgcn_exp2f(s.y);
    const f32x2 m = v * (q * e), r = v - m;
    f32x2 o; o.x = v.x < 0.f ? m.x : r.x; o.y = v.y < 0.f ? m.y : r.y; return o;
}
__device__ __forceinline__ unsigned pk_h2(float lo, float hi) { typedef _Float16 h2 __attribute__((ext_vector_type(2))); h2 v; v.x = (h16)lo; v.y = (h16)hi; return __builtin_bit_cast(unsigned, v); }
__device__ __forceinline__ u32x4 pk_h8(f32x4 a, f32x4 b) { u32x4 w; w.x = pk_h2(a[0], a[1]); w.y = pk_h2(a[2], a[3]); w.z = pk_h2(b[0], b[1]); w.w = pk_h2(b[2], b[3]); return w; }

template <class Epi, bool ALIGN_EPI = true>
__device__ __forceinline__ void gemm_phase(PG8_LAS unsigned char* lds, const Gemm g, const StaticOrder& S, const Epi& E) {
    int tid = threadIdx.x; asm volatile("" : "+v"(tid));
    const int wid = __builtin_amdgcn_readfirstlane(tid >> 6), lane = tid & 63, wr = wid >> 2, wc = wid & 3, fr = lane & 15, fq = lane >> 4;
    const int K = g.K, nt = K / BK;
    unsigned voffA[2], voffB[2];
#pragma unroll
    for (int i = 0; i < 2; ++i) { int R, C; stage_rc(tid * 16 + i * 8192, R, C); const int Rb = (R & ~31) + perm32(R & 31);
        voffA[i] = (unsigned)(R * K + C) * 2u; voffB[i] = (unsigned)(Rb * K + C) * 2u; }
    const size_t kstep = (size_t)(BK * 2);
    const size_t hstep = (size_t)HALF * K * 2;
    const size_t tstep = 2 * hstep;
    const unsigned ldsw = (unsigned)wid * 1024u;
    const int aoff = lds_byte(wr * 64 + fr, fq * 8), boff = lds_byte(wc * 32 + fr, fq * 8);
#define PG8_SA(b, h) (((b) * 2 + (h)) * HTB)
#define PG8_SB(b, h) ((4 + (b) * 2 + (h)) * HTB)
#define PG8_STAGE(bufoff, gbase, voff) do { _Pragma("unroll") for (int _i = 0; _i < 2; ++_i) \
        __builtin_amdgcn_global_load_lds((const unsigned*)((const char*)(gbase) + (voff)[_i]), (PG8_LAS unsigned*)(lds + (bufoff) + ldsw + _i * 8192), 16, 0, 0); } while (0)
#define PG8_LDA(dst, b, h) do { _Pragma("unroll") for (int m = 0; m < 4; ++m) _Pragma("unroll") for (int k = 0; k < 2; ++k) dst[m][k] = *(const PG8_LAS h16x8*)(lds + PG8_SA(b, h) + aoff + m * 2048 + k * 1024); } while (0)
#define PG8_LDB(dst, b, h) do { _Pragma("unroll") for (int n = 0; n < 2; ++n) _Pragma("unroll") for (int k = 0; k < 2; ++k) dst[n][k] = *(const PG8_LAS h16x8*)(lds + PG8_SB(b, h) + boff + n * 2048 + k * 1024); } while (0)
#define PG8_MMA(ai, bj, At, Bt) do { __builtin_amdgcn_s_setprio(1); _Pragma("unroll") for (int m = 0; m < 4; ++m) _Pragma("unroll") for (int n = 0; n < 2; ++n) _Pragma("unroll") for (int k = 0; k < 2; ++k) \
        acc[ai][bj][m][n] = __builtin_amdgcn_mfma_f32_16x16x32_f16(Bt[n][k], At[m][k], acc[ai][bj][m][n], 0, 0, 0); __builtin_amdgcn_s_setprio(0); } while (0)
#define PG8_WAIT_V(n) asm volatile("s_waitcnt vmcnt(" #n ")" ::: "memory")
#define PG8_WAIT_L(n) asm volatile("s_waitcnt lgkmcnt(" #n ")" ::: "memory")
#define PG8_BAR __builtin_amdgcn_s_barrier()
#define PG8_SCHED __builtin_amdgcn_sched_barrier(0)
    Unit cur, nxt; int ui = 0;
    if (!S.next(0, cur)) return;
    f32x4 acc[2][2][4][2];
#pragma unroll
    for (int a = 0; a < 2; ++a)
#pragma unroll
        for (int b = 0; b < 2; ++b)
#pragma unroll
            for (int m = 0; m < 4; ++m)
#pragma unroll
                for (int n = 0; n < 2; ++n) acc[a][b][m][n] = (f32x4){0.f, 0.f, 0.f, 0.f};
    h16x8 At[4][2], B0[2][2], B1[2][2];
    const char* cA = (const char*)g.A + (size_t)cur.pm * tstep; const char* cB = (const char*)g.Bt + (size_t)cur.pn * tstep;
    PG8_STAGE(PG8_SB(0, 0), cB, voffB); PG8_STAGE(PG8_SB(0, 1), cB + hstep, voffB); PG8_STAGE(PG8_SA(0, 0), cA, voffA); PG8_STAGE(PG8_SA(0, 1), cA + hstep, voffA);
    if (wr == 1) PG8_BAR;
    PG8_WAIT_V(2); PG8_BAR;
    PG8_STAGE(PG8_SB(1, 0), cB + kstep, voffB); PG8_STAGE(PG8_SA(1, 0), cA + kstep, voffA); PG8_STAGE(PG8_SB(1, 1), cB + hstep + kstep, voffB);
    PG8_WAIT_V(6); PG8_BAR;
    for (;;) {
        const bool has_next = S.next(ui + 1, nxt);
        const char* nA = has_next ? (const char*)g.A + (size_t)nxt.pm * tstep : cA; const char* nB = has_next ? (const char*)g.Bt + (size_t)nxt.pn * tstep : cB;
#pragma unroll 1
        for (int t = 0; t < nt; t += 2) {
            const bool last = (t == nt - 2);
            const char* a1 = cA + (size_t)(t + 1) * kstep;
            const char* a2 = last ? nA : cA + (size_t)(t + 2) * kstep; const char* b2 = last ? nB : cB + (size_t)(t + 2) * kstep;
            const char* a3 = a2 + kstep; const char* b3 = b2 + kstep;
            PG8_LDB(B0, 0, 0); PG8_LDB(B1, 0, 1); PG8_SCHED; PG8_LDA(At, 0, 0); PG8_STAGE(PG8_SA(1, 1), a1 + hstep, voffA);
            PG8_WAIT_V(8); PG8_WAIT_L(0); PG8_BAR; PG8_MMA(0, 0, At, B0); PG8_MMA(0, 1, At, B1); PG8_BAR; PG8_SCHED;
            PG8_LDA(At, 0, 1); PG8_STAGE(PG8_SB(0, 0), b2, voffB); PG8_STAGE(PG8_SB(0, 1), b2 + hstep, voffB); PG8_STAGE(PG8_SA(0, 0), a2, voffA);
            PG8_WAIT_V(8); PG8_WAIT_L(0); PG8_BAR; PG8_MMA(1, 0, At, B0); PG8_MMA(1, 1, At, B1); PG8_BAR; PG8_SCHED;
            PG8_LDB(B0, 1, 0); PG8_LDB(B1, 1, 1); PG8_SCHED; PG8_LDA(At, 1, 0); PG8_STAGE(PG8_SA(0, 1), a2 + hstep, voffA);
            PG8_WAIT_V(8); PG8_WAIT_L(0); PG8_BAR; PG8_MMA(0, 0, At, B0); PG8_MMA(0, 1, At, B1); PG8_BAR; PG8_SCHED;
            PG8_LDA(At, 1, 1); PG8_STAGE(PG8_SB(1, 0), b3, voffB); PG8_STAGE(PG8_SB(1, 1), b3 + hstep, voffB); PG8_STAGE(PG8_SA(1, 0), a3, voffA);
            PG8_WAIT_V(8); PG8_WAIT_L(0); PG8_BAR; PG8_MMA(1, 0, At, B0); PG8_MMA(1, 1, At, B1); PG8_BAR; PG8_SCHED;
        }
        if constexpr (ALIGN_EPI) { if (wr == 0) PG8_BAR; }
        { int fr_ = fr, fq_ = fq; asm volatile("" : "+v"(fr_), "+v"(fq_));
          E(acc, cur, wr, wc, fr_, fq_); }
        if (!has_next) break;
#pragma unroll
        for (int a = 0; a < 2; ++a)
#pragma unroll
            for (int b = 0; b < 2; ++b)
#pragma unroll
                for (int m = 0; m < 4; ++m)
#pragma unroll
                    for (int n = 0; n < 2; ++n) acc[a][b][m][n] = (f32x4){0.f, 0.f, 0.f, 0.f};
        cur = nxt; cA = nA; cB = nB; ++ui;
        if constexpr (ALIGN_EPI) { if (wr == 1) PG8_BAR; }
    }
    PG8_WAIT_V(0);
    if constexpr (!ALIGN_EPI) { if (wr == 0) PG8_BAR; }
    PG8_BAR;
#undef PG8_SA
#undef PG8_SB
#undef PG8_STAGE
#undef PG8_LDA
#undef PG8_LDB
#undef PG8_MMA
#undef PG8_WAIT_V
#undef PG8_WAIT_L
#undef PG8_BAR
#undef PG8_SCHED
}

struct EpiOut {
    h16* Y; float* ssy;
    __device__ __forceinline__ void operator()(const f32x4 (&acc)[2][2][4][2], const Unit& u, int wr, int wc, int fr, int fq) const {
        const int row0 = u.pm * BM + wr * 64 + fr, col0 = u.pn * BM + wc * 32 + 8 * fq;
#pragma unroll
        for (int ai = 0; ai < 2; ++ai)
#pragma unroll
            for (int m = 0; m < 4; ++m) { const int row = row0 + ai * HALF + m * 16; h16* rowp = Y + (size_t)row * DM + col0; float s = 0.f;
#pragma unroll
                for (int bj = 0; bj < 2; ++bj) { const f32x4 v0 = acc[ai][bj][m][0], v1 = acc[ai][bj][m][1];
                    s += (v0[0] * v0[0] + v0[1] * v0[1]) + (v0[2] * v0[2] + v0[3] * v0[3]) + (v1[0] * v1[0] + v1[1] * v1[1]) + (v1[2] * v1[2] + v1[3] * v1[3]);
                    *(u32x4*)(rowp + bj * HALF) = pk_h8(v0, v1); }
                s += __shfl_xor(s, 16); s += __shfl_xor(s, 32);
                if (fq == 0) atomicAdd(ssy + row, s); }
    }
};

__device__ __forceinline__ float silu_f(float v) { return v * __builtin_amdgcn_rcpf(1.0f + __builtin_amdgcn_exp2f(-1.4426950408889634f * v)); }
struct EpiProj {
    h16 *U, *V, *ZA, *ZB, *CQ, *KV, *KIDX; float *CKVR, *WIDX, *ssq, *sskv; const float* rope;
    __device__ __forceinline__ void operator()(const f32x4 (&acc)[2][2][4][2], const Unit& u, int wr, int wc, int fr, int fq) const {
        const int row0 = u.pm * BM + wr * 64 + fr, pn = u.pn;
        if (pn < 8) {
            h16* base = (pn < 2 ? U : pn < 4 ? V : pn < 6 ? ZA : ZB) + (pn & 1) * 256 + wc * 32 + 8 * fq;
            const bool is_gelu = pn < 4;
#pragma unroll
            for (int ai = 0; ai < 2; ++ai)
#pragma unroll
                for (int m = 0; m < 4; ++m) { h16* rowp = base + (size_t)(row0 + ai * HALF + m * 16) * GW;
#pragma unroll
                    for (int bj = 0; bj < 2; ++bj) { f32x4 v0 = acc[ai][bj][m][0], v1 = acc[ai][bj][m][1];
                        if (is_gelu) { const f32x2 a = gelu_pk((f32x2){v0[0], v0[1]}), b = gelu_pk((f32x2){v0[2], v0[3]}), c = gelu_pk((f32x2){v1[0], v1[1]}), d = gelu_pk((f32x2){v1[2], v1[3]});
                            v0 = (f32x4){a.x, a.y, b.x, b.y}; v1 = (f32x4){c.x, c.y, d.x, d.y}; }
                        else { v0 = (f32x4){silu_f(v0[0]), silu_f(v0[1]), silu_f(v0[2]), silu_f(v0[3])}; v1 = (f32x4){silu_f(v1[0]), silu_f(v1[1]), silu_f(v1[2]), silu_f(v1[3])}; }
                        *(u32x4*)(rowp + bj * HALF) = pk_h8(v0, v1); } }
        } else if (pn == 8) {
            const int col0 = wc * 32 + 8 * fq;
#pragma unroll
            for (int ai = 0; ai < 2; ++ai)
#pragma unroll
                for (int m = 0; m < 4; ++m) { const int row = row0 + ai * HALF + m * 16; h16* rowp = CQ + (size_t)row * QR + col0; float s = 0.f;
#pragma unroll
                    for (int bj = 0; bj < 2; ++bj) { const f32x4 v0 = acc[ai][bj][m][0], v1 = acc[ai][bj][m][1];
                        s += (v0[0] * v0[0] + v0[1] * v0[1]) + (v0[2] * v0[2] + v0[3] * v0[3]) + (v1[0] * v1[0] + v1[1] * v1[1]) + (v1[2] * v1[2] + v1[3] * v1[3]);
                        *(u32x4*)(rowp + bj * HALF) = pk_h8(v0, v1); }
                    s += __shfl_xor(s, 16); s += __shfl_xor(s, 32);
                    if (fq == 0) atomicAdd(ssq + row, s); }
        } else {
#pragma unroll
            for (int ai = 0; ai < 2; ++ai)
#pragma unroll
                for (int m = 0; m < 4; ++m) { const int row = row0 + ai * HALF + m * 16;
                    { const f32x4 v0 = acc[ai][0][m][0], v1 = acc[ai][0][m][1];
                        float s = (v0[0] * v0[0] + v0[1] * v0[1]) + (v0[2] * v0[2] + v0[3] * v0[3]) + (v1[0] * v1[0] + v1[1] * v1[1]) + (v1[2] * v1[2] + v1[3] * v1[3]);
                        float* p = CKVR + (size_t)row * CKV + wc * 32 + 8 * fq; *(f32x4*)p = v0; *(f32x4*)(p + 4) = v1;
                        s += __shfl_xor(s, 16); s += __shfl_xor(s, 32);
                        if (fq == 0) atomicAdd(sskv + row, s); }
                    const f32x4 x1 = acc[ai][1][m][0], x2 = acc[ai][1][m][1];
                    if (wc == 0) {
                        const int pos = row & (SEQ - 1); const float* rp = rope + (size_t)pos * 32 + 8 * fq;
                        const f32x4 r0 = *(const f32x4*)rp, r1 = *(const f32x4*)(rp + 4);
                        const float o1a = x1[0] * r0[0] - x2[0] * r0[1], o2a = x2[0] * r0[0] + x1[0] * r0[1];
                        const float o1b = x1[1] * r0[2] - x2[1] * r0[3], o2b = x2[1] * r0[2] + x1[1] * r0[3];
                        const float o1c = x1[2] * r1[0] - x2[2] * r1[1], o2c = x2[2] * r1[0] + x1[2] * r1[1];
                        const float o1d = x1[3] * r1[2] - x2[3] * r1[3], o2d = x2[3] * r1[2] + x1[3] * r1[3];
                        h16* p = KV + (size_t)row * KVD + CKV + 4 * fq;
                        typedef unsigned u32x2 __attribute__((ext_vector_type(2)));
                        *(u32x2*)p = (u32x2){pk_h2(o1a, o1b), pk_h2(o1c, o1d)}; *(u32x2*)(p + 16) = (u32x2){pk_h2(o2a, o2b), pk_h2(o2c, o2d)};
                    } else if (wc < 3) {
                        *(u32x4*)(KIDX + (size_t)row * IDXD + (wc - 1) * 32 + 8 * fq) = pk_h8(x1, x2);
                    } else if (fq == 0) {
                        float* p = WIDX + (size_t)row * NH; *(f32x4*)p = x1 * 0.044194173824159216f; *(f32x4*)(p + 4) = x2 * 0.044194173824159216f;
                    } }
        }
    }
};

struct EpiQ {
    h16 *QA, *QIDX; const float* ssq; const float* rope;
    template <int RS, int BS>
    __device__ __forceinline__ void plain(const f32x4 (&acc)[2][2][4][2], h16* base, int row0) const {
#pragma unroll
        for (int ai = 0; ai < 2; ++ai)
#pragma unroll
            for (int m = 0; m < 4; ++m) { const int row = row0 + ai * HALF + m * 16; const float rstd = rsqrtf(ssq[row] * (1.f / QR) + EPS);
                h16* rowp = base + (size_t)row * RS;
#pragma unroll
                for (int bj = 0; bj < 2; ++bj) *(u32x4*)(rowp + bj * BS) = pk_h8(acc[ai][bj][m][0] * rstd, acc[ai][bj][m][1] * rstd);
                asm volatile("" ::: "memory"); }
    }
    __device__ __forceinline__ void operator()(const f32x4 (&acc)[2][2][4][2], const Unit& u, int wr, int wc, int fr, int fq) const {
        const int row0 = u.pm * BM + wr * 64 + fr, pn = u.pn;
        if (pn < 4) plain<NH * KVD, KVD>(acc, QA + (2 * pn) * KVD + wc * 32 + 8 * fq, row0);
        else if (pn < 6) plain<512, HALF>(acc, QIDX + (pn - 4) * 256 + wc * 32 + 8 * fq, row0);
        else {
#pragma unroll
            for (int ai = 0; ai < 2; ++ai)
#pragma unroll
                for (int m = 0; m < 4; ++m) { const int row = row0 + ai * HALF + m * 16; const float rstd = rsqrtf(ssq[row] * (1.f / QR) + EPS);
                    const int pos = row & (SEQ - 1); const float* rp = rope + (size_t)pos * 32 + 8 * fq;
                    const f32x4 r0 = *(const f32x4*)rp * rstd, r1 = *(const f32x4*)(rp + 4) * rstd;
#pragma unroll
                    for (int bj = 0; bj < 2; ++bj) { const f32x4 v0 = acc[ai][bj][m][0], v1 = acc[ai][bj][m][1];
                        const float o1a = v0[0] * r0[0] - v1[0] * r0[1], o2a = v1[0] * r0[0] + v0[0] * r0[1];
                        const float o1b = v0[1] * r0[2] - v1[1] * r0[3], o2b = v1[1] * r0[2] + v0[1] * r0[3];
                        const float o1c = v0[2] * r1[0] - v1[2] * r1[1], o2c = v1[2] * r1[0] + v0[2] * r1[1];
                        const float o1d = v0[3] * r1[2] - v1[3] * r1[3], o2d = v1[3] * r1[2] + v0[3] * r1[3];
                        h16* p = QA + (size_t)row * (NH * KVD) + (4 * bj + wc) * KVD + CKV + 4 * fq;
                        typedef unsigned u32x2 __attribute__((ext_vector_type(2)));
                        *(u32x2*)p = (u32x2){pk_h2(o1a, o1b), pk_h2(o1c, o1d)}; *(u32x2*)(p + 16) = (u32x2){pk_h2(o2a, o2b), pk_h2(o2c, o2d)}; }
                    asm volatile("" ::: "memory"); }
        }
    }
};
}

constexpr int NTHREADS = 512;
constexpr int LDS_BYTES = 147456;


__device__ __forceinline__ void ckvnorm_phase(const Args& a) {
    int tid_ = threadIdx.x; asm volatile("" : "+v"(tid_));
    unsigned char* ws = a.ws; const float* CKVR = (const float*)(ws + WS_CKVR); const float* sskv = (const float*)(ws + WS_SSKV); h16* KV = (h16*)(ws + WS_KV);
    { const h16* KIDX = (const h16*)(ws + WS_KIDX); unsigned* kmax = (unsigned*)(ws + WS_KMAX);
      for (int tok = blockIdx.x * blockDim.x + tid_; tok < T; tok += gridDim.x * blockDim.x) { float s = 0.f;
        for (int e = 0; e < 8; ++e) { const h16x8 v = *(const h16x8*)(KIDX + (size_t)tok * IDXD + 8 * e); for (int k = 0; k < 8; ++k) s += (float)v[k] * (float)v[k]; }
        for (int o = 1; o < 64; o <<= 1) s = fmaxf(s, __shfl_xor(s, o));
        if ((tid_ & 63) == 0) atomicMax(kmax + tok / SEQ, __float_as_uint(s)); } }
    for (int i = blockIdx.x * blockDim.x + tid_; i < T * 16; i += gridDim.x * blockDim.x) {
        const int tok = i >> 4, c = (i & 15) * 8; const float rstd = rsqrtf(sskv[tok] * (1.f / CKV) + EPS);
        const f32x4 v0 = *(const f32x4*)(CKVR + (size_t)tok * CKV + c), v1 = *(const f32x4*)(CKVR + (size_t)tok * CKV + c + 4);
        const f32x4 g0 = *(const f32x4*)(a.kvn_g + c), g1 = *(const f32x4*)(a.kvn_g + c + 4);
        *(pg8::u32x4*)(KV + (size_t)tok * KVD + c) = pg8::pk_h8(v0 * rstd * g0, v1 * rstd * g1);
    }
}


namespace p3 {
#define LAS __attribute__((address_space(3)))
typedef float f32x16 __attribute__((ext_vector_type(16)));
typedef short s16x4 __attribute__((ext_vector_type(4)));
typedef unsigned u32x4 __attribute__((ext_vector_type(4)));
typedef unsigned u32x2 __attribute__((ext_vector_type(2)));
constexpr int CC = 96;
constexpr int L_SEL = 0;
constexpr int L_META = 16384;
constexpr int L_WQ = L_META + 1024;
constexpr int L_QN = L_WQ + 1024;
constexpr int L_MISC = L_QN + 1024;
constexpr int L_QS = 20480, QS_STRIDE = 1040;
constexpr int L_HIST = L_QS + 32 * QS_STRIDE;
constexpr int L_CAND = L_HIST + 65536;
constexpr int L_VBUF = 20480;
constexpr int L_OLAT = L_VBUF + 65536, OL_STRIDE = 2064;
constexpr int L_END = L_OLAT + 32 * OL_STRIDE;
static_assert(L_CAND + 32 * CC * 8 <= L_END, "lds map");

__device__ __forceinline__ float med3(float a, float b, float c) { return __builtin_amdgcn_fmed3f(a, b, c); }

constexpr unsigned KBASE = 0x3C000000u >> 7;
constexpr unsigned K1 = (512u << 10) - KBASE, K2 = (512u << 10) - 1u + KBASE;
template <int PASS>
__device__ __forceinline__ void index_pass(LAS unsigned char* lds, const h16* kb, int nslab, int wid, int lane) {
    asm volatile("" : "+v"(lane));
    const int r = lane & 31, hh = lane >> 5;
    float w[8];
    { const f32x4 w0 = *(const LAS f32x4*)(lds + L_WQ + r * 32), w1 = *(const LAS f32x4*)(lds + L_WQ + r * 32 + 16);
      w[0] = w0[0]; w[1] = w0[1]; w[2] = w0[2]; w[3] = w0[3]; w[4] = w1[0]; w[5] = w1[1]; w[6] = w1[2]; w[7] = w1[3]; }
    const float sp = *(const LAS float*)(lds + L_META + r * 4), sn = *(const LAS float*)(lds + L_META + 128 + r * 4);
    unsigned tlo = 0u, thi = 0u;
    if (PASS >= 2) { tlo = *(const LAS unsigned*)(lds + L_META + 256 + r * 4); thi = *(const LAS unsigned*)(lds + L_META + 768 + r * 4); }
    const LAS unsigned char* qbase = lds + L_QS + r * QS_STRIDE + hh * 16;
    LAS unsigned* hist = (LAS unsigned*)(lds + L_HIST + r * 2048);
    LAS unsigned* selcnt = (LAS unsigned*)(lds + L_META + 512 + r * 4);
    LAS unsigned* candcnt = (LAS unsigned*)(lds + L_META + 640 + r * 4);
    LAS unsigned short* sel = (LAS unsigned short*)(lds + L_SEL) + r * 256;
    LAS u32x2* cand = (LAS u32x2*)(lds + L_CAND) + r * CC;
    h16x8 a[4];
    int s = wid;
    if (s < nslab) { const h16* kp = kb + (size_t)(s * 32 + r) * IDXD + hh * 8;
#pragma unroll
        for (int ks = 0; ks < 4; ++ks) a[ks] = *(const h16x8*)(kp + 16 * ks); }
    for (; s < nslab; s += 8) {
        h16x8 an[4];
        { const int sn_ = (s + 8 < nslab) ? s + 8 : s; const h16* kp = kb + (size_t)(sn_ * 32 + r) * IDXD + hh * 8;
#pragma unroll
          for (int ks = 0; ks < 4; ++ks) an[ks] = *(const h16x8*)(kp + 16 * ks); }
        f32x16 score;
#pragma unroll
        for (int i = 0; i < 16; ++i) score[i] = 0.f;
#pragma unroll
        for (int h = 0; h < 8; ++h) {
            f32x16 acc;
#pragma unroll
            for (int i = 0; i < 16; ++i) acc[i] = 0.f;
#pragma unroll
            for (int ks = 0; ks < 4; ++ks) acc = __builtin_amdgcn_mfma_f32_32x32x16_f16(a[ks], *(const LAS h16x8*)(qbase + h * 128 + ks * 32), acc, 0, 0, 0);
#pragma unroll
            for (int i = 0; i < 16; ++i) score[i] = __builtin_fmaf(w[h], __builtin_fmaxf(acc[i], 0.f), score[i]);
        }
#pragma unroll
        for (int i = 0; i < 16; ++i) {
            const float sc = score[i]; const bool pos = sc >= 0.f;
            const float v = __builtin_fminf(__builtin_fmaf(__builtin_fabsf(sc), pos ? sp : sn, 0.0078125f), 1.99f);
            const unsigned x = __float_as_uint(v) >> 7;
            const unsigned ck = pos ? x + K1 : K2 - x;
            if (PASS == 1) { const unsigned bin = ck >> 10; __hip_atomic_fetch_add(hist + (bin >> 1), 1u << ((bin & 1u) * 16u), __ATOMIC_RELAXED, __HIP_MEMORY_SCOPE_WORKGROUP); }
            else if (PASS == 2) { if ((ck >> 10) == tlo) { const unsigned sub = ck & 1023u; __hip_atomic_fetch_add(hist + (sub >> 1), 1u << ((sub & 1u) * 16u), __ATOMIC_RELAXED, __HIP_MEMORY_SCOPE_WORKGROUP); } }
            else if (ck >= tlo) {
                const unsigned key = (unsigned)(s * 32 + (i & 3) + 8 * (i >> 2) + 4 * hh);
                if (ck >= thi) { const unsigned p = __hip_atomic_fetch_add(selcnt, 1u, __ATOMIC_RELAXED, __HIP_MEMORY_SCOPE_WORKGROUP); if (p < 256u) sel[p] = (unsigned short)key; }
                else { const unsigned p = __hip_atomic_fetch_add(candcnt, 1u, __ATOMIC_RELAXED, __HIP_MEMORY_SCOPE_WORKGROUP); if (p < (unsigned)CC) cand[p] = (u32x2){__float_as_uint(sc), key}; }
            }
        }
#pragma unroll
        for (int ks = 0; ks < 4; ++ks) a[ks] = an[ks];
    }
}

__device__ __forceinline__ void find_thr(LAS unsigned char* lds, int q, unsigned need, int lane, int& tbin, unsigned& nabove, unsigned& nin) {
    const LAS u32x4* hq = (const LAS u32x4*)(lds + L_HIST + q * 2048 + lane * 32); const u32x4 wa = hq[0], wb = hq[1];
    unsigned wv[8] = {wa[0], wa[1], wa[2], wa[3], wb[0], wb[1], wb[2], wb[3]}; unsigned tot = 0;
#pragma unroll
    for (int e = 0; e < 8; ++e) tot += (wv[e] & 0xffffu) + (wv[e] >> 16);
    unsigned sfx = tot;
#pragma unroll
    for (int o = 1; o < 64; o <<= 1) { const unsigned t = __shfl_down(sfx, o); if (lane + o < 64) sfx += t; }
    const unsigned long long bal = __ballot(sfx >= need);
    const int L = bal ? 63 - __builtin_clzll(bal) : 0;
    unsigned above = sfx - tot, nab = above, ni = 0; bool found = false; int tb = 16 * lane;
#pragma unroll
    for (int e = 7; e >= 0; --e) { const unsigned c1 = wv[e] >> 16, c0 = wv[e] & 0xffffu;
        if (!found && above + c1 >= need) { found = true; tb = 16 * lane + 2 * e + 1; nab = above; ni = c1; }
        if (!found) above += c1;
        if (!found && above + c0 >= need) { found = true; tb = 16 * lane + 2 * e; nab = above; ni = c0; }
        if (!found) above += c0; }
    tbin = __shfl(tb, L); nabove = __shfl(nab, L); nin = __shfl(ni, L);
}

__device__ __forceinline__ void attn_query(LAS unsigned char* lds, const h16* qa, const h16* kvb, int qi, int cnt, int wid, int lane) {
    asm volatile("" : "+v"(lane));
    const int c15 = lane & 15, g = lane >> 4, k7 = c15 & 7;
    h16x8 qb[5];
#pragma unroll
    for (int ks = 0; ks < 5; ++ks) { h16x8 z; for (int e = 0; e < 8; ++e) z[e] = (h16)0.f; qb[ks] = c15 < 8 ? *(const h16x8*)(qa + c15 * KVD + 32 * ks + 8 * g) : z; }
    f32x4 o[8];
#pragma unroll
    for (int ct = 0; ct < 8; ++ct) o[ct] = (f32x4){0.f, 0.f, 0.f, 0.f};
    float m_run = -INFINITY, l_part = 0.f;
    const LAS unsigned short* sel = (const LAS unsigned short*)(lds + L_SEL) + qi * 256;
    LAS unsigned char* vb = lds + L_VBUF + wid * 8192;
    LAS unsigned char* wrow = vb + c15 * 256;
    const int kt = 4 * g + (c15 >> 2), pp = c15 & 3;
    const unsigned trbase = (unsigned)(uintptr_t)(vb + kt * 256 + 16 * (pp >> 1) + 8 * (pp & 1));
    const int kt7 = kt & 7;
    const int nch = cnt >> 5;
    constexpr float SC = 0.10206207261596577f * 1.4426950408889634f;
    for (int c = 0; c < nch; ++c) {
        const int i0 = sel[32 * c + c15], i1 = sel[32 * c + 16 + c15];
        const h16* r0 = kvb + (size_t)i0 * KVD + 8 * g; const h16* r1 = kvb + (size_t)i1 * KVD + 8 * g;
        h16x8 a0[5], a1[5];
#pragma unroll
        for (int ks = 0; ks < 5; ++ks) { a0[ks] = *(const h16x8*)(r0 + 32 * ks); a1[ks] = *(const h16x8*)(r1 + 32 * ks); }
#pragma unroll
        for (int ks = 0; ks < 4; ++ks) { const int ch = ((4 * ks + g) ^ (2 * k7)) << 4; *(LAS h16x8*)(wrow + ch) = a0[ks]; *(LAS h16x8*)(wrow + 4096 + ch) = a1[ks]; }
        f32x4 s0 = (f32x4){0.f, 0.f, 0.f, 0.f}, s1 = (f32x4){0.f, 0.f, 0.f, 0.f};
#pragma unroll
        for (int ks = 0; ks < 5; ++ks) { s0 = __builtin_amdgcn_mfma_f32_16x16x32_f16(a0[ks], qb[ks], s0, 0, 0, 0); s1 = __builtin_amdgcn_mfma_f32_16x16x32_f16(a1[ks], qb[ks], s1, 0, 0, 0); }
        s0 = s0 * SC; s1 = s1 * SC;
        float mx = fmaxf(fmaxf(fmaxf(s0[0], s0[1]), fmaxf(s0[2], s0[3])), fmaxf(fmaxf(s1[0], s1[1]), fmaxf(s1[2], s1[3])));
        mx = fmaxf(mx, __shfl_xor(mx, 16)); mx = fmaxf(mx, __shfl_xor(mx, 32));
        const float mn = fmaxf(m_run, mx), alpha = __builtin_amdgcn_exp2f(m_run - mn);
        f32x4 p0, p1;
#pragma unroll
        for (int e = 0; e < 4; ++e) { p0[e] = __builtin_amdgcn_exp2f(s0[e] - mn); p1[e] = __builtin_amdgcn_exp2f(s1[e] - mn); }
        l_part = l_part * alpha + ((p0[0] + p0[1]) + (p0[2] + p0[3])) + ((p1[0] + p1[1]) + (p1[2] + p1[3]));
        m_run = mn;
#pragma unroll
        for (int ct = 0; ct < 8; ++ct) o[ct] = o[ct] * alpha;
        h16x8 pb; pb[0] = (h16)p0[0]; pb[1] = (h16)p0[1]; pb[2] = (h16)p0[2]; pb[3] = (h16)p0[3]; pb[4] = (h16)p1[0]; pb[5] = (h16)p1[1]; pb[6] = (h16)p1[2]; pb[7] = (h16)p1[3];
        s16x4 lo[8], hi[8];
#pragma unroll
        for (int ct = 0; ct < 8; ++ct) { const unsigned ad = trbase + (unsigned)((ct ^ kt7) << 5);
            asm volatile("ds_read_b64_tr_b16 %0, %1" : "=&v"(lo[ct]) : "v"(ad) : "memory");
            asm volatile("ds_read_b64_tr_b16 %0, %1 offset:4096" : "=&v"(hi[ct]) : "v"(ad) : "memory"); }
        asm volatile("s_waitcnt lgkmcnt(0)" ::: "memory"); __builtin_amdgcn_sched_barrier(0);
#pragma unroll
        for (int ct = 0; ct < 8; ++ct) { const s16x4 l4 = lo[ct], h4 = hi[ct];
            typedef short s16x8 __attribute__((ext_vector_type(8)));
            const s16x8 va = (s16x8){l4[0], l4[1], l4[2], l4[3], h4[0], h4[1], h4[2], h4[3]};
            o[ct] = __builtin_amdgcn_mfma_f32_16x16x32_f16(__builtin_bit_cast(h16x8, va), pb, o[ct], 0, 0, 0); }
    }
    float l = l_part; l += __shfl_xor(l, 16); l += __shfl_xor(l, 32);
    const float inv = 1.0f / l;
    if (c15 < 8) {
        LAS unsigned char* op = lds + L_OLAT + qi * OL_STRIDE + c15 * 256 + 8 * g;
#pragma unroll
        for (int ct = 0; ct < 8; ++ct) { h16x4 v; v[0] = (h16)(o[ct][0] * inv); v[1] = (h16)(o[ct][1] * inv); v[2] = (h16)(o[ct][2] * inv); v[3] = (h16)(o[ct][3] * inv);
            *(LAS h16x4*)(op + 32 * ct) = v; }
    }
}

__device__ __forceinline__ void phase(LAS unsigned char* lds, unsigned char* ws) {
    int tid = threadIdx.x; asm volatile("" : "+v"(tid));
    const int wid = __builtin_amdgcn_readfirstlane(tid >> 6), lane = tid & 63;
    const h16* QIDX = (const h16*)(ws + WS_QIDX); const h16* KIDX = (const h16*)(ws + WS_KIDX); const float* WIDX = (const float*)(ws + WS_WIDX);
    const h16* QA = (const h16*)(ws + WS_QA); const h16* KV = (const h16*)(ws + WS_KV); const h16* WuvT = (const h16*)(ws + WS_WUVT);
    const h16* ZB = (const h16*)(ws + WS_ZB); h16* A2 = (h16*)(ws + WS_A2);
    unsigned* qctr = (unsigned*)(ws + WS_QUEUE); const unsigned* kmaxp = (const unsigned*)(ws + WS_KMAX);
    const int queue = blockIdx.x & 7, b = queue >> 1;
    LAS int* misc = (LAS int*)(lds + L_MISC);
    for (;;) {
        if (tid == 0) misc[0] = (int)atomicAdd(qctr + queue * 64, 1u);
        __syncthreads();
        const int j = misc[0];
        if (j >= 128) break;
        const int qt = 255 - 2 * j - (queue & 1), q0 = qt * 32, tok0 = b * SEQ + q0, N = ((q0 >> 6) + 1) * 64;
        for (int i = tid; i < 1024; i += NTHREADS) ((LAS u32x4*)(lds + L_SEL))[i] = (u32x4){0u, 0u, 0u, 0u};
        if (N <= TOPK) {
            __syncthreads();
            for (int i = tid; i < 32 * 256; i += NTHREADS) { const int jj = i & 255; if (jj < N) ((LAS unsigned short*)(lds + L_SEL))[i] = (unsigned short)jj; }
        } else {
            { const int q = tid >> 4, part = tid & 15; const h16* src = QIDX + (size_t)(tok0 + q) * 512 + part * 32; LAS unsigned char* dst = lds + L_QS + q * QS_STRIDE + part * 64;
#pragma unroll
              for (int e = 0; e < 4; ++e) *(LAS h16x8*)(dst + 16 * e) = *(const h16x8*)(src + 8 * e); }
            if (tid < 256) ((LAS float*)(lds + L_WQ))[tid] = WIDX[(size_t)tok0 * 8 + tid];
#pragma unroll
            for (int e = 0; e < 8; ++e) ((LAS u32x4*)(lds + L_HIST))[tid + e * NTHREADS] = (u32x4){0u, 0u, 0u, 0u};
            if (tid < 64) ((LAS unsigned*)(lds + L_META + 512))[tid] = 0u;
            __syncthreads();
            if (tid < 256) { const int q = tid >> 3, h = tid & 7; const LAS unsigned char* p = lds + L_QS + q * QS_STRIDE + h * 128; float s = 0.f;
#pragma unroll
                for (int e = 0; e < 8; ++e) { const h16x8 v = *(const LAS h16x8*)(p + 16 * e);
#pragma unroll
                    for (int k = 0; k < 8; ++k) s += (float)v[k] * (float)v[k]; }
                ((LAS float*)(lds + L_QN))[tid] = sqrtf(s); }
            __syncthreads();
            if (tid < 32) { const float kmax = sqrtf(__uint_as_float(__hip_atomic_load(kmaxp + b, __ATOMIC_RELAXED, __HIP_MEMORY_SCOPE_AGENT))); float bp = 0.f, bn = 0.f;
#pragma unroll
                for (int h = 0; h < 8; ++h) { const float wv = ((const LAS float*)(lds + L_WQ))[tid * 8 + h], t = fabsf(wv) * ((const LAS float*)(lds + L_QN))[tid * 8 + h] * kmax; if (wv > 0.f) bp += t; else bn += t; }
                ((LAS float*)(lds + L_META))[tid] = bp > 0.f ? 1.0f / (bp * 1.0005f) : 0.f; ((LAS float*)(lds + L_META + 128))[tid] = bn > 0.f ? 1.0f / (bn * 1.0005f) : 0.f; }
            if (tid == 0) misc[1] = 0;
            __syncthreads();
            const h16* kb = KIDX + (size_t)b * SEQ * IDXD; const int nslab = N >> 5;
            index_pass<1>(lds, kb, nslab, wid, lane);
            __syncthreads();
            for (int i = 0; i < 4; ++i) { const int q = wid * 4 + i; int tbin; unsigned nab, nin;
                find_thr(lds, q, (unsigned)TOPK, lane, tbin, nab, nin);
                if (lane == 0) { const bool fl = nin > (unsigned)CC;
                    ((LAS unsigned*)(lds + L_META + 256))[q] = fl ? (unsigned)tbin : ((unsigned)tbin << 10);
                    ((LAS unsigned*)(lds + L_META + 768))[q] = fl ? 1u : (((unsigned)tbin + 1u) << 10);
                    ((LAS int*)(lds + L_META + 384))[q] = (int)nab;
                    if (fl) misc[1] = 1; } }
            __syncthreads();
            if (misc[1] != 0) {
#pragma unroll
                for (int e = 0; e < 8; ++e) ((LAS u32x4*)(lds + L_HIST))[tid + e * NTHREADS] = (u32x4){0u, 0u, 0u, 0u};
                unsigned myflag = 0, mytb = 0;
                if (tid < 32) { myflag = ((const LAS unsigned*)(lds + L_META + 768))[tid] == 1u; mytb = ((const LAS unsigned*)(lds + L_META + 256))[tid]; }
                __syncthreads();
                if (tid < 32 && !myflag) ((LAS unsigned*)(lds + L_META + 256))[tid] = 0xffffffffu;
                __syncthreads();
                index_pass<2>(lds, kb, nslab, wid, lane);
                __syncthreads();
                if (tid < 32 && !myflag) ((LAS unsigned*)(lds + L_META + 256))[tid] = mytb;
                for (int i = 0; i < 4; ++i) { const int q = wid * 4 + i;
                    const bool fl = ((const LAS unsigned*)(lds + L_META + 768))[q] == 1u;
                    if (fl) { const unsigned tb1 = ((const LAS unsigned*)(lds + L_META + 256))[q]; const int nab1 = ((const LAS int*)(lds + L_META + 384))[q];
                        int tsub; unsigned nab2, nin2; find_thr(lds, q, (unsigned)(TOPK - nab1), lane, tsub, nab2, nin2);
                        if (lane == 0) { const unsigned tl = (tb1 << 10) | (unsigned)tsub;
                            ((LAS unsigned*)(lds + L_META + 256))[q] = tl; ((LAS unsigned*)(lds + L_META + 768))[q] = tl + 1u; ((LAS int*)(lds + L_META + 384))[q] = nab1 + (int)nab2; } } }
                __syncthreads();
            }
            index_pass<3>(lds, kb, nslab, wid, lane);
            __syncthreads();
            for (int i = 0; i < 4; ++i) { const int q = wid * 4 + i;
                const unsigned mc = ((const LAS unsigned*)(lds + L_META + 640))[q]; const int m = mc < (unsigned)CC ? (int)mc : CC;
                const int nab = ((const LAS int*)(lds + L_META + 384))[q], need = TOPK - nab;
                const LAS u32x2* cd = (const LAS u32x2*)(lds + L_CAND) + q * CC;
                for (int c = lane; c < m; c += 64) { const u32x2 me = cd[c]; const float sc = __uint_as_float(me[0]); int rank = 0;
                    for (int k = 0; k < m; ++k) { const u32x2 ot = cd[k]; const float so = __uint_as_float(ot[0]); rank += (so > sc || (so == sc && ot[1] < me[1])) ? 1 : 0; }
                    if (rank < need) ((LAS unsigned short*)(lds + L_SEL))[q * 256 + nab + rank] = (unsigned short)me[1]; } }
        }
        __syncthreads();
        const int cnt = N < TOPK ? N : TOPK;
        for (int i = 0; i < 4; ++i) { const int qi = wid * 4 + i; attn_query(lds, QA + (size_t)(tok0 + qi) * (NH * KVD), KV + (size_t)b * SEQ * KVD, qi, cnt, wid, lane); }
        __syncthreads();
        {
            int lane2 = lane; asm volatile("" : "+v"(lane2));
            const int r = lane2 & 31, hh = lane2 >> 5;
            f32x16 acc0, acc1;
#pragma unroll
            for (int i = 0; i < 16; ++i) { acc0[i] = 0.f; acc1[i] = 0.f; }
            const h16* wu = WuvT + (size_t)(wid * 64 + r) * 128 + 8 * hh;
            const LAS unsigned char* ap = lds + L_OLAT + r * OL_STRIDE + wid * 256 + 16 * hh;
#pragma unroll
            for (int ks = 0; ks < 8; ++ks) { const h16x8 af = *(const LAS h16x8*)(ap + 32 * ks); const h16x8 b0 = *(const h16x8*)(wu + 16 * ks), b1 = *(const h16x8*)(wu + 32 * 128 + 16 * ks);
                acc0 = __builtin_amdgcn_mfma_f32_32x32x16_f16(af, b0, acc0, 0, 0, 0); acc1 = __builtin_amdgcn_mfma_f32_32x32x16_f16(af, b1, acc1, 0, 0, 0); }
#pragma unroll
            for (int i = 0; i < 16; ++i) { const int q = (i & 3) + 8 * (i >> 2) + 4 * hh; const size_t tok = (size_t)(tok0 + q); const int col = wid * 64 + r;
                const float g0 = (float)ZB[tok * GW + col], g1 = (float)ZB[tok * GW + col + 32];
                A2[tok * DM + 512 + col] = (h16)(acc0[i] * g0); A2[tok * DM + 512 + col + 32] = (h16)(acc1[i] * g1); }
        }
        __syncthreads();
    }
}
}


__device__ __forceinline__ void final_phase(const Args& a) {
    int tid_ = threadIdx.x; asm volatile("" : "+v"(tid_));
    const h16* Y = (const h16*)(a.ws + WS_Y); const float* ssy = (const float*)(a.ws + WS_SSY);
    const size_t n4 = (size_t)T * DM / 4;
    for (size_t i = (size_t)blockIdx.x * blockDim.x + tid_; i < n4; i += (size_t)gridDim.x * blockDim.x) {
        const int row = (int)(i >> 8), c4 = (int)(i & 255);
        const float rstd = rsqrtf(ssy[row] * (1.f / DM) + EPS);
        const f32x4 xv = *((const f32x4*)a.x + i); const f32x4 g = *((const f32x4*)a.post_g + c4); const h16x4 yv = *((const h16x4*)Y + i);
        f32x4 o; o.x = xv.x + (float)yv.x * rstd * g.x; o.y = xv.y + (float)yv.y * rstd * g.y; o.z = xv.z + (float)yv.z * rstd * g.z; o.w = xv.w + (float)yv.w * rstd * g.w;
        *((f32x4*)a.out + i) = o;
    }
}


namespace gm {
constexpr int L_VN = 0;
constexpr int L_ST = 32768;
__device__ __forceinline__ int swz(int row) { return 2 * ((row & 3) | (((row >> 3) & 1) << 2)); }
__device__ __forceinline__ void phase(LAS unsigned char* lds, const Args& a) {
    unsigned char* ws = a.ws;
    const h16* U = (const h16*)(ws + WS_U); const h16* V = (const h16*)(ws + WS_V); const h16* ZA = (const h16*)(ws + WS_ZA);
    const h16* WsH = (const h16*)(ws + WS_WSH); h16* A2 = (h16*)(ws + WS_A2);
    int tid = threadIdx.x; asm volatile("" : "+v"(tid));
    const int wid = __builtin_amdgcn_readfirstlane(tid >> 6), lane = tid & 63;
    for (int nb = blockIdx.x; nb < T / 128; nb += gridDim.x) {
        const int tok0 = nb * 128;
        {
            const int row = tid >> 2, part = tid & 3; const h16* vr = V + (size_t)(tok0 + row) * GW + part * 128; float s = 0.f, q = 0.f;
#pragma unroll 4
            for (int e = 0; e < 16; ++e) { const h16x8 v = *(const h16x8*)(vr + 8 * e);
#pragma unroll
                for (int k = 0; k < 8; ++k) { const float f = (float)v[k]; s += f; q += f * f; } }
            s += __shfl_xor(s, 1); s += __shfl_xor(s, 2); q += __shfl_xor(q, 1); q += __shfl_xor(q, 2);
            const float m = s * (1.f / GW), var = fmaxf(q * (1.f / GW) - m * m, 0.f);
            if (part == 0) { ((LAS float*)(lds + L_ST))[row] = m; ((LAS float*)(lds + L_ST))[128 + row] = rsqrtf(var + EPS); } }
        __syncthreads();
        for (int g = 0; g < 4; ++g) {
            {
                const int row = tid >> 2, part = tid & 3; const float m = ((const LAS float*)(lds + L_ST))[row], rs = ((const LAS float*)(lds + L_ST))[128 + row];
                const h16* vr = V + (size_t)(tok0 + row) * GW + g * 128 + part * 32; const float* lg = a.ln_g + g * 128 + part * 32; const float* lb = a.ln_b + g * 128 + part * 32;
                const int sw = swz(row);
#pragma unroll
                for (int e = 0; e < 4; ++e) { const h16x8 v = *(const h16x8*)(vr + 8 * e); h16x8 o;
#pragma unroll
                    for (int k = 0; k < 8; ++k) o[k] = (h16)(((float)v[k] - m) * rs * lg[8 * e + k] + lb[8 * e + k]);
                    *(LAS h16x8*)(lds + L_VN + row * 256 + (((part * 4 + e) ^ sw) << 4)) = o; } }
            __syncthreads();
            {
                const int c15 = lane & 15, gq = lane >> 4, qq = c15 >> 2, pp = c15 & 3;
                const h16* wp = WsH + (size_t)(g * 128 + wid * 16 + c15) * 128 + 8 * gq;
                h16x8 wf[4];
#pragma unroll
                for (int ks = 0; ks < 4; ++ks) wf[ks] = *(const h16x8*)(wp + 32 * ks);
                f32x4 acc[8];
#pragma unroll
                for (int ct = 0; ct < 8; ++ct) acc[ct] = (f32x4){0.f, 0.f, 0.f, 0.f};
#pragma unroll
                for (int ks = 0; ks < 4; ++ks) {
                    const int r0 = 32 * ks + 8 * gq + qq, r1 = r0 + 4;
                    const unsigned b0 = (unsigned)(uintptr_t)(lds + L_VN + r0 * 256 + 16 * (pp >> 1) + 8 * (pp & 1)), b1 = (unsigned)(uintptr_t)(lds + L_VN + r1 * 256 + 16 * (pp >> 1) + 8 * (pp & 1));
                    const int s0 = swz(r0) >> 1, s1 = swz(r1) >> 1;
                    p3::s16x4 lo[8], hi[8];
#pragma unroll
                    for (int ct = 0; ct < 8; ++ct) { const unsigned a0 = b0 + (unsigned)((ct ^ s0) << 5), a1 = b1 + (unsigned)((ct ^ s1) << 5);
                        asm volatile("ds_read_b64_tr_b16 %0, %1" : "=&v"(lo[ct]) : "v"(a0) : "memory");
                        asm volatile("ds_read_b64_tr_b16 %0, %1" : "=&v"(hi[ct]) : "v"(a1) : "memory"); }
                    asm volatile("s_waitcnt lgkmcnt(0)" ::: "memory"); __builtin_amdgcn_sched_barrier(0);
#pragma unroll
                    for (int ct = 0; ct < 8; ++ct) { typedef short s16x8 __attribute__((ext_vector_type(8)));
                        const s16x8 va = (s16x8){lo[ct][0], lo[ct][1], lo[ct][2], lo[ct][3], hi[ct][0], hi[ct][1], hi[ct][2], hi[ct][3]};
                        acc[ct] = __builtin_amdgcn_mfma_f32_16x16x32_f16(__builtin_bit_cast(h16x8, va), wf[ks], acc[ct], 0, 0, 0); }
                }
                const int tl = wid * 16 + c15; const float bs = a.b_s[g * 128 + tl]; const size_t tok = (size_t)(tok0 + tl);
#pragma unroll
                for (int ct = 0; ct < 8; ++ct) { const int ch = g * 128 + 16 * ct + 4 * gq;
                    const h16x4 uu = *(const h16x4*)(U + tok * GW + ch), zz = *(const h16x4*)(ZA + tok * GW + ch); h16x4 o;
#pragma unroll
                    for (int e = 0; e < 4; ++e) o[e] = (h16)((float)uu[e] * (acc[ct][e] + bs) * (float)zz[e]);
                    *(h16x4*)(A2 + tok * DM + ch) = o; }
            }
            __syncthreads();
        }
    }
}
}

#define XB_TMO      128
#define XB_XCNT(j)  (256  + 64 * (j))
#define XB_XSUB(j)  (1280 + 64 * (j))
#define XB_XGEN(j)  (2304 + 64 * (j))
#define XB_TOP      3328
#define XB_TOPGEN   3392
#define XCD_BAR_WORDS 3456
#define XB_SPIN_CAP (1u << 18)
__device__ __forceinline__ unsigned xb_ld(unsigned* p)              { return __hip_atomic_load(p, __ATOMIC_RELAXED, __HIP_MEMORY_SCOPE_AGENT); }
__device__ __forceinline__ unsigned xb_add(unsigned* p, unsigned v) { return __hip_atomic_fetch_add(p, v, __ATOMIC_RELAXED, __HIP_MEMORY_SCOPE_AGENT); }
__device__ __forceinline__ unsigned xb_xcc_id() { return (unsigned)__builtin_amdgcn_s_getreg((3 << 11) | 20) & 0xFu; }
#define XB_SPIN(cond, bar) do { unsigned _sp = 0; while (cond) { __builtin_amdgcn_s_sleep(1); \
    if ((++_sp & 255u) == 0u) { if (xb_ld(&(bar)[XB_TMO])) break; if (_sp > XB_SPIN_CAP) { atomicAdd(&(bar)[XB_TMO], 1u); break; } } } } while (0)
struct XcdBarrier { unsigned* bar; unsigned x; volatile LAS unsigned* st; };
__device__ __forceinline__ XcdBarrier xcd_barrier_post(unsigned* bar, volatile LAS unsigned* st) {
    XcdBarrier b; b.bar = bar; b.x = xb_xcc_id(); b.st = st;
    if (threadIdx.x == 0) (void)xb_add(&bar[XB_XCNT(b.x)], 1u);
    return b;
}
__device__ __forceinline__ void xcd_barrier_complete(unsigned* bar, unsigned x, unsigned& nloc, unsigned& nx) {
    const unsigned G = gridDim.x * gridDim.y * gridDim.z;
    unsigned sum, cnt, mine, sp = 0u;
    for (;;) {
        sum = 0u; cnt = 0u; mine = 0u;
#pragma unroll
        for (unsigned j = 0; j < 16; ++j) { const unsigned c = xb_ld(&bar[XB_XCNT(j)]); sum += c; cnt += (c > 0u) ? 1u : 0u; mine = (j == x) ? c : mine; }
        if (sum == G) break;
        __builtin_amdgcn_s_sleep(1);
        if ((++sp & 255u) == 0u) { if (xb_ld(&bar[XB_TMO])) break; if (sp > XB_SPIN_CAP) { atomicAdd(&bar[XB_TMO], 1u); break; } }
    }
    nloc = mine > 0u ? mine : 1u; nx = cnt > 0u ? cnt : 1u;
}
__device__ __forceinline__ void xcd_barrier(const XcdBarrier& b) {
    asm volatile("s_waitcnt vmcnt(0)" ::: "memory");
    __syncthreads();
    if (threadIdx.x == 0) {
        unsigned* bar = b.bar;
        __builtin_amdgcn_s_waitcnt(0);
        unsigned nloc = b.st[0], nx = b.st[1];
        if (nloc == 0u) { xcd_barrier_complete(bar, b.x, nloc, nx); b.st[0] = nloc; b.st[1] = nx; }
        const unsigned old = xb_add(&bar[XB_XSUB(b.x)], 1u);
        const unsigned gen = old / nloc;
        if (old + 1u == (gen + 1u) * nloc) {
            __builtin_amdgcn_fence(__ATOMIC_RELEASE, "agent");
            asm volatile("s_waitcnt vmcnt(0)" ::: "memory");
            const unsigned og = xb_add(&bar[XB_TOP], 1u);
            const unsigned tg = og / nx;
            if (og + 1u == (tg + 1u) * nx) xb_add(&bar[XB_TOPGEN], 1u);
            else XB_SPIN(xb_ld(&bar[XB_TOPGEN]) == tg, bar);
            __builtin_amdgcn_fence(__ATOMIC_ACQUIRE, "agent");
            xb_add(&bar[XB_XGEN(b.x)], 1u);
            asm volatile("s_waitcnt vmcnt(0)" ::: "memory");
        } else {
            XB_SPIN(xb_ld(&bar[XB_XGEN(b.x)]) == gen, bar);
            __builtin_amdgcn_fence(__ATOMIC_ACQUIRE, "agent");
            asm volatile("s_waitcnt vmcnt(0)" ::: "memory");
        }
    }
    __syncthreads();
}

#ifndef MK_PER_PHASE
#define MK_PER_PHASE 0
#endif
constexpr int LDS_TOTAL = 153600;
constexpr int L_BARST = LDS_TOTAL - 64;
constexpr size_t WS_BAR = 16384;
static_assert(p3::L_END <= L_BARST && pg8::STAGE_BYTES <= L_BARST && WS_BAR + XCD_BAR_WORDS * 4 <= WS_SSQ, "maps");

struct MArgs { Args a; int ph_lo, ph_hi; };
__global__ __launch_bounds__(NTHREADS, 2) void mega(MArgs m) {
    extern __shared__ __attribute__((aligned(16))) unsigned char lds_raw[];
    LAS unsigned char* lds = (LAS unsigned char*)lds_raw;
    const Args& a = m.a; unsigned char* ws = a.ws;
    volatile LAS unsigned* st = (volatile LAS unsigned*)(lds + L_BARST);
    if (threadIdx.x < 16) st[threadIdx.x] = 0u;
    __syncthreads();
    XcdBarrier bar; bar.bar = (unsigned*)(ws + WS_BAR); bar.x = 0; bar.st = st;
    if (!MK_PER_PHASE) bar = xcd_barrier_post((unsigned*)(ws + WS_BAR), st);
#define IN(k) (m.ph_lo <= (k) && (k) < m.ph_hi)
#define SEAM(k) do { if (IN(k) && IN((k) + 1)) xcd_barrier(bar); } while (0)
    if (IN(0)) { prep_weights(a); prep_x(a); }
    SEAM(0);
    if (IN(1)) {
        pg8::Gemm g{(const h16*)(ws + WS_X16), (const h16*)(ws + WS_WINT), T, NP, DM};
        pg8::StaticOrder S; S.init(T, NP, gridDim.x, blockIdx.x);
        pg8::EpiProj E{(h16*)(ws + WS_U), (h16*)(ws + WS_V), (h16*)(ws + WS_ZA), (h16*)(ws + WS_ZB), (h16*)(ws + WS_CQ), (h16*)(ws + WS_KV), (h16*)(ws + WS_KIDX),
                       (float*)(ws + WS_CKVR), (float*)(ws + WS_WIDX), (float*)(ws + WS_SSQ), (float*)(ws + WS_SSKV), (const float*)(ws + WS_ROPE)};
        pg8::gemm_phase<pg8::EpiProj, true>(lds, g, S, E);
    }
    SEAM(1);
    if (IN(2)) {
        { pg8::Gemm g{(const h16*)(ws + WS_CQ), (const h16*)(ws + WS_W2T), T, N2, QR};
          pg8::StaticOrder S; S.init(T, N2, gridDim.x, blockIdx.x);
          pg8::EpiQ E{(h16*)(ws + WS_QA), (h16*)(ws + WS_QIDX), (const float*)(ws + WS_SSQ), (const float*)(ws + WS_ROPE)};
          pg8::gemm_phase<pg8::EpiQ, true>(lds, g, S, E); }
        gm::phase(lds, a);
        ckvnorm_phase(a);
    }
    SEAM(2);
    if (IN(3)) p3::phase(lds, ws);
    SEAM(3);
    if (IN(4)) {
        pg8::Gemm g{(const h16*)(ws + WS_A2), (const h16*)(ws + WS_WOUTT), T, DM, DM};
        pg8::StaticOrder S; S.init(T, DM, gridDim.x, blockIdx.x);
        pg8::EpiOut E{(h16*)(ws + WS_Y), (float*)(ws + WS_SSY)};
        pg8::gemm_phase<pg8::EpiOut, true>(lds, g, S, E);
    }
    SEAM(4);
    if (IN(5)) final_phase(a);
#undef IN
#undef SEAM
}

extern "C" void kernel_launch(void* const* d_in, const int* in_sizes, int n_in, void* d_out, int out_size, void* d_ws, size_t ws_size, hipStream_t stream) {
    static int grid = 0;
    if (grid == 0) {
        if (n_in != 15 || ws_size < WS_END) { fprintf(stderr, "kernel_launch: unexpected n_in %d / ws %zu\n", n_in, ws_size); grid = -1; return; }
        int dev = 0, cus = 0;
        if (hipGetDevice(&dev) != hipSuccess || hipDeviceGetAttribute(&cus, hipDeviceAttributeMultiprocessorCount, dev) != hipSuccess) { grid = -1; return; }
        if (hipFuncSetAttribute((const void*)mega, hipFuncAttributeMaxDynamicSharedMemorySize, LDS_TOTAL) != hipSuccess) { fprintf(stderr, "kernel_launch: hipFuncSetAttribute failed\n"); grid = -1; return; }
        grid = cus;
    }
    if (grid < 0) return;
    (void)hipMemsetAsync((char*)d_ws + WS_CTL, 0, 1 * MiB, stream);
    MArgs m{};
    Args& a = m.a;
    a.x = (const float*)d_in[0]; a.w_in = (const float*)d_in[1]; a.pre_g = (const float*)d_in[2]; a.post_g = (const float*)d_in[3];
    a.ln_g = (const float*)d_in[4]; a.ln_b = (const float*)d_in[5]; a.w_s = (const float*)d_in[6]; a.b_s = (const float*)d_in[7];
    a.qn_g = (const float*)d_in[8]; a.kvn_g = (const float*)d_in[9]; a.w_uq = (const float*)d_in[10]; a.w_uk = (const float*)d_in[11];
    a.w_uv = (const float*)d_in[12]; a.w_qidx = (const float*)d_in[13]; a.w_out = (const float*)d_in[14];
    a.out = (float*)d_out; a.ws = (unsigned char*)d_ws;
#if MK_PER_PHASE
    for (int p = 0; p < 6; ++p) { m.ph_lo = p; m.ph_hi = p + 1; hipLaunchKernelGGL(mega, dim3(grid), dim3(NTHREADS), LDS_TOTAL, stream, m); }
#else
    m.ph_lo = 0; m.ph_hi = 6;
    hipLaunchKernelGGL(mega, dim3(grid), dim3(NTHREADS), LDS_TOTAL, stream, m);
#endif
}
```

```cpp
#include <hip/hip_runtime.h>
#ifndef REP_PHASE
#define REP_PHASE -1
#endif
#include <cstdio>
#include <cstdint>

typedef _Float16 h16;
typedef _Float16 h16x8 __attribute__((ext_vector_type(8)));
typedef _Float16 h16x4 __attribute__((ext_vector_type(4)));
typedef float f32x4 __attribute__((ext_vector_type(4)));

constexpr int BATCH = 4, SEQ = 8192, T = BATCH * SEQ, DM = 1024;
constexpr int NIN = 2536, NP = 2560;
constexpr int GW = 512;
constexpr int QR = 256, CKV = 128, ROPE = 32, IDXD = 64, NH = 8;
constexpr int KVD = CKV + ROPE;
constexpr int N2 = 1792;
constexpr int TOPK = 256;
constexpr float EPS = 1e-6f;
constexpr int C_U = 0, C_V = 512, C_ZA = 1024, C_ZB = 1536, C_CQ = 2048, C_CKV = 2304, C_KR = 2432, C_KI = 2464, C_WI = 2528;
__host__ __device__ inline int old_col(int n) {
    if (n < 1536) return n;
    if (n < 2048) return 2024 + (n - 1536);
    if (n < 2304) return 1536 + (n - 2048);
    if (n < 2432) return 1792 + (n - 2304);
    if (n < 2464) { const int rho = n - 2432; return 1920 + 16 * ((rho >> 2) & 1) + 4 * (rho >> 3) + (rho & 3); }
    if (n < 2528) return 1952 + (n - 2464);
    if (n < 2536) return 2016 + (n - 2528);
    return -1;
}

constexpr size_t MiB = 1u << 20;
constexpr size_t WS_CTL = 0;
constexpr size_t WS_SSQ = 64 * 1024;
constexpr size_t WS_SSKV = WS_SSQ + T * 4;
constexpr size_t WS_SSY = WS_SSKV + T * 4;
constexpr size_t WS_KMAX = WS_SSY + T * 4;
constexpr size_t WS_QUEUE = 4096;
constexpr size_t WS_WINT = 1 * MiB;
constexpr size_t WS_W2T = 6 * MiB;
constexpr size_t WS_WOUTT = 7 * MiB;
constexpr size_t WS_WUVT = 9 * MiB;
constexpr size_t WS_WSH = 9 * MiB + 256 * 1024;
constexpr size_t WS_ROPE = 10 * MiB;
constexpr size_t WS_WIDX = 11 * MiB;
constexpr size_t WS_CNT = 12 * MiB;
constexpr size_t WS_KIDX = 13 * MiB;
constexpr size_t WS_KV = 17 * MiB;
constexpr size_t WS_CQ = 27 * MiB;
constexpr size_t WS_CKVR = 43 * MiB;
constexpr size_t WS_SEL = 59 * MiB;
constexpr size_t WS_X16 = 75 * MiB;
constexpr size_t WS_Y = WS_X16;
constexpr size_t WS_U = 139 * MiB;
constexpr size_t WS_V = 171 * MiB;
constexpr size_t WS_ZA = 203 * MiB;
constexpr size_t WS_ZB = 235 * MiB;
constexpr size_t WS_QIDX = 267 * MiB;
constexpr size_t WS_QA = 299 * MiB;
constexpr size_t WS_A2 = 379 * MiB;
constexpr size_t WS_END = 491 * MiB;
__host__ __device__ inline size_t scache_off(int wg) { return wg < 48 ? (27 + (size_t)wg) * MiB : wg < 208 ? (75 + (size_t)(wg - 48)) * MiB : (443 + (size_t)(wg - 208)) * MiB; }

struct Args {
    const float* x; const float* w_in; const float* pre_g; const float* post_g; const float* ln_g; const float* ln_b;
    const float* w_s; const float* b_s; const float* qn_g; const float* kvn_g; const float* w_uq; const float* w_uk;
    const float* w_uv; const float* w_qidx; const float* w_out;
    float* out; unsigned char* ws;
};


__device__ __forceinline__ int lane_id() { int l; asm volatile("v_mbcnt_lo_u32_b32 %0, -1, 0\n\tv_mbcnt_hi_u32_b32 %0, -1, %0" : "=v"(l)); return l; }
#define TID() ((int)threadIdx.x)
__device__ __forceinline__ float gelu_erf(float v) { return 0.5f * v * (1.0f + erff(v * 0.70710678118654752f)); }
__device__ __forceinline__ float silu(float v) { return v / (1.0f + __expf(-v)); }

__device__ __forceinline__ void prep_weights(const Args& a, const int g_wid) {
    int tid_ = TID(); asm volatile("" : "+v"(tid_));
    const int gtid = blockIdx.x * blockDim.x + tid_, gsz = gridDim.x * blockDim.x;
    unsigned char* ws = a.ws;
    h16* WinT = (h16*)(ws + WS_WINT);
    for (int i = gtid; i < NP * DM; i += gsz) {
        const int k = i / NP, n = i % NP, oc = old_col(n);
        WinT[(size_t)n * DM + k] = (h16)(oc >= 0 ? a.w_in[(size_t)k * NIN + oc] : 0.f);
    }
    h16* W2T = (h16*)(ws + WS_W2T);
    for (int i = gtid; i < N2 * QR; i += gsz) {
        const int k = i / N2, n = i % N2; float v;
        if (n < 1024) { const int h = n >> 7, c = n & 127; float s = 0.f;
            for (int d = 0; d < 64; ++d) s += a.w_uq[(size_t)k * 768 + h * 96 + d] * a.w_uk[(size_t)c * 512 + h * 64 + d];
            v = s;
        } else if (n < 1536) { v = a.w_qidx[(size_t)k * 512 + (n - 1024)]; }
        else { const int j = n - 1536, h = j >> 5, rho = j & 31, r = 16 * ((rho >> 2) & 1) + 4 * (rho >> 3) + (rho & 3); v = a.w_uq[(size_t)k * 768 + h * 96 + 64 + r]; }
        W2T[(size_t)n * QR + k] = (h16)(v * a.qn_g[k]);
    }
    h16* WoutT = (h16*)(ws + WS_WOUTT);
    for (int i = gtid; i < DM * DM; i += gsz) { const int k = i / DM, n = i % DM; WoutT[(size_t)n * DM + k] = (h16)a.w_out[i]; }
    h16* WuvT = (h16*)(ws + WS_WUVT);
    for (int i = gtid; i < 128 * 512; i += gsz) { const int c = i / 512, hd = i % 512, h = hd >> 6, d = hd & 63; WuvT[(size_t)(h * 64 + d) * 128 + c] = (h16)a.w_uv[i]; }
    h16* WsH = (h16*)(ws + WS_WSH);
    for (int i = gtid; i < 4 * 128 * 128; i += gsz) { const int t = (i >> 7) & 127, s = i & 127; WsH[i] = (h16)(((s >> 6) <= (t >> 6)) ? a.w_s[i] : 0.f); }
    float2* rope = (float2*)(ws + WS_ROPE);
    for (int i = gtid; i < SEQ * 16; i += gsz) {
        const int pos = i >> 4, j = i & 15;
        const double invf = exp2(-(double)j * (13.287712379549449 / 16.0));
        const double ang = (double)pos * invf;
        const double n = rint(ang * 0.15915494309189535);
        const float r = (float)(ang - n * 6.283185307179586);
        rope[i] = make_float2(cosf(r), sinf(r));
    }
}

__device__ __forceinline__ void prep_x(const Args& a, const int g_wid) {
    int tid_ = TID(); asm volatile("" : "+v"(tid_));
    const int lane = tid_ & 63, gw = (blockIdx.x * blockDim.x + tid_) >> 6, ngw = (gridDim.x * blockDim.x) >> 6;
    h16* X16 = (h16*)(a.ws + WS_X16);
    for (int row = gw; row < T; row += ngw) {
        const f32x4* xr = (const f32x4*)(a.x + (size_t)row * DM) + lane;
        f32x4 v[4]; float s = 0.f;
#pragma unroll
        for (int j = 0; j < 4; ++j) { v[j] = xr[64 * j]; s += (v[j].x * v[j].x + v[j].y * v[j].y) + (v[j].z * v[j].z + v[j].w * v[j].w); }
#pragma unroll
        for (int o = 1; o < 64; o <<= 1) s += __shfl_xor(s, o);
        const float rstd = rsqrtf(s * (1.f / DM) + EPS);
#pragma unroll
        for (int j = 0; j < 4; ++j) {
            const f32x4 g = *((const f32x4*)a.pre_g + lane + 64 * j);
            h16x4 o; o.x = (h16)(v[j].x * rstd * g.x); o.y = (h16)(v[j].y * rstd * g.y); o.z = (h16)(v[j].z * rstd * g.z); o.w = (h16)(v[j].w * rstd * g.w);
            *((h16x4*)(X16 + (size_t)row * DM) + lane + 64 * j) = o;
        }
    }
}

namespace pg8 {
#define PG8_LAS __attribute__((address_space(3)))
typedef unsigned u32x4 __attribute__((ext_vector_type(4)));
typedef float f32x2 __attribute__((ext_vector_type(2)));
constexpr int BM = 256, BK = 64, HALF = 128, HTB = HALF * BK * 2, STAGE_BYTES = 8 * HTB, NXCD = 8, WGM = 8;
__host__ __device__ __forceinline__ int lds_byte(int r, int c) { const int st = (r >> 4) * 2 + (c >> 5), rr = r & 15, cc = c & 31, ob = rr * 64 + cc * 2; return st * 1024 + (ob ^ (((ob >> 9) & 1) << 5)); }
__host__ __device__ __forceinline__ void stage_rc(int b, int& R, int& C) { const int st = b / 1024, sb = b % 1024, swz = sb ^ (((sb >> 9) & 1) << 5); R = (st >> 1) * 16 + swz / 64; C = (st & 1) * 32 + (swz % 64) / 2; }
__host__ __device__ __forceinline__ int perm32(int rho) { const int n = rho >> 4, i = rho & 15; return 8 * (i >> 2) + 4 * n + (i & 3); }
struct Unit { int pm, pn; };
struct Gemm { const h16* A; const h16* Bt; int M, N, K; };
struct StaticOrder {
    int nM, nN, nwg, G, c;
    __host__ __device__ void init(int M, int N, int G_, int c_) { nM = M / BM; nN = N / BM; nwg = nM * nN; G = G_; c = c_; }
    __host__ __device__ bool next(int i, Unit& u) const {
        const long L = (long)i * G + c; if (L >= nwg) return false;
        int wgid = (int)L; { const int q = nwg / NXCD, r = nwg % NXCD, xcd = wgid % NXCD, off = wgid / NXCD; wgid = (xcd < r ? xcd * (q + 1) : r * (q + 1) + (xcd - r) * q) + off; }
        const int nig = WGM * nN, gid = wgid / nig, fm = gid * WGM, gsz = (nM - fm) < WGM ? (nM - fm) : WGM;
        u.pm = fm + ((wgid % nig) % gsz); u.pn = (wgid % nig) / gsz; return true;
    }
};
__device__ __forceinline__ f32x2 gelu_pk(f32x2 v) {
    const f32x2 av = __builtin_elementwise_abs(v), d = av * 0.2316418882f + 1.0f;
    f32x2 t; t.x = __builtin_amdgcn_rcpf(d.x); t.y = __builtin_amdgcn_rcpf(d.y);
    f32x2 q = t * 0.5307027145f + (-0.7265760135f); q = q * t + 0.7107068705f; q = q * t + (-0.142248368f); q = q * t + 0.127414796f; q = q * t;
    const f32x2 s = (v * v) * (-0.72134752044f);
    f32x2 e; e.x = __builtin_amdgcn_exp2f(s.x); e.y = __builtin_amdgcn_exp2f(s.y);
    const f32x2 m = v * (q * e), r = v - m;
    f32x2 o; o.x = v.x < 0.f ? m.x : r.x; o.y = v.y < 0.f ? m.y : r.y; return o;
}
__device__ __forceinline__ unsigned pk_h2(float lo, float hi) { typedef _Float16 h2 __attribute__((ext_vector_type(2))); h2 v; v.x = (h16)lo; v.y = (h16)hi; return __builtin_bit_cast(unsigned, v); }
__device__ __forceinline__ u32x4 pk_h8(f32x4 a, f32x4 b) { u32x4 w; w.x = pk_h2(a[0], a[1]); w.y = pk_h2(a[2], a[3]); w.z = pk_h2(b[0], b[1]); w.w = pk_h2(b[2], b[3]); return w; }

template <class Epi, bool ALIGN_EPI = true>
__device__ __forceinline__ void gemm_phase(PG8_LAS unsigned char* lds, const Gemm g, const StaticOrder& S, const Epi& E, const int g_wid) {
    int tid = TID(); asm volatile("" : "+v"(tid));
    const int wid = __builtin_amdgcn_readfirstlane(tid >> 6), lane = tid & 63, wr = wid >> 2, wc = wid & 3, fr = lane & 15, fq = lane >> 4;
    const int K = g.K, nt = K / BK;
    unsigned voffA[2], voffB[2];
#pragma unroll
    for (int i = 0; i < 2; ++i) { int R, C; stage_rc(tid * 16 + i * 8192, R, C); const int Rb = (R & ~31) + perm32(R & 31);
        voffA[i] = (unsigned)(R * K + C) * 2u; voffB[i] = (unsigned)(Rb * K + C) * 2u; }
    const size_t kstep = (size_t)(BK * 2);
    const size_t hstep = (size_t)HALF * K * 2;
    const size_t tstep = 2 * hstep;
    const unsigned ldsw = (unsigned)wid * 1024u;
    const int aoff = lds_byte(wr * 64 + fr, fq * 8), boff = lds_byte(wc * 32 + fr, fq * 8);
#define PG8_SA(b, h) (((b) * 2 + (h)) * HTB)
#define PG8_SB(b, h) ((4 + (b) * 2 + (h)) * HTB)
#define PG8_STAGE(bufoff, gbase, voff) do { _Pragma("unroll") for (int _i = 0; _i < 2; ++_i) \
        __builtin_amdgcn_global_load_lds((const unsigned*)((const char*)(gbase) + (voff)[_i]), (PG8_LAS unsigned*)(lds + (bufoff) + ldsw + _i * 8192), 16, 0, 0); } while (0)
#define PG8_LDA(dst, b, h) do { _Pragma("unroll") for (int m = 0; m < 4; ++m) _Pragma("unroll") for (int k = 0; k < 2; ++k) dst[m][k] = *(const PG8_LAS h16x8*)(lds + PG8_SA(b, h) + aoff + m * 2048 + k * 1024); } while (0)
#define PG8_LDB(dst, b, h) do { _Pragma("unroll") for (int n = 0; n < 2; ++n) _Pragma("unroll") for (int k = 0; k < 2; ++k) dst[n][k] = *(const PG8_LAS h16x8*)(lds + PG8_SB(b, h) + boff + n * 2048 + k * 1024); } while (0)
#define PG8_MMA(ai, bj, At, Bt) do { __builtin_amdgcn_s_setprio(1); _Pragma("unroll") for (int m = 0; m < 4; ++m) _Pragma("unroll") for (int n = 0; n < 2; ++n) _Pragma("unroll") for (int k = 0; k < 2; ++k) \
        acc[ai][bj][m][n] = __builtin_amdgcn_mfma_f32_16x16x32_f16(Bt[n][k], At[m][k], acc[ai][bj][m][n], 0, 0, 0); __builtin_amdgcn_s_setprio(0); } while (0)
#define PG8_WAIT_V(n) asm volatile("s_waitcnt vmcnt(" #n ")" ::: "memory")
#define PG8_WAIT_L(n) asm volatile("s_waitcnt lgkmcnt(" #n ")" ::: "memory")
#define PG8_BAR __builtin_amdgcn_s_barrier()
#define PG8_SCHED __builtin_amdgcn_sched_barrier(0)
    Unit cur, nxt; int ui = 0;
    if (!S.next(0, cur)) return;
    f32x4 acc[2][2][4][2];
#pragma unroll
    for (int a = 0; a < 2; ++a)
#pragma unroll
        for (int b = 0; b < 2; ++b)
#pragma unroll
            for (int m = 0; m < 4; ++m)
#pragma unroll
                for (int n = 0; n < 2; ++n) acc[a][b][m][n] = (f32x4){0.f, 0.f, 0.f, 0.f};
    h16x8 At[4][2], B0[2][2], B1[2][2];
    const char* cA = (const char*)g.A + (size_t)cur.pm * tstep; const char* cB = (const char*)g.Bt + (size_t)cur.pn * tstep;
    PG8_STAGE(PG8_SB(0, 0), cB, voffB); PG8_STAGE(PG8_SB(0, 1), cB + hstep, voffB); PG8_STAGE(PG8_SA(0, 0), cA, voffA); PG8_STAGE(PG8_SA(0, 1), cA + hstep, voffA);
    if (wr == 1) PG8_BAR;
    PG8_WAIT_V(2); PG8_BAR;
    PG8_STAGE(PG8_SB(1, 0), cB + kstep, voffB); PG8_STAGE(PG8_SA(1, 0), cA + kstep, voffA); PG8_STAGE(PG8_SB(1, 1), cB + hstep + kstep, voffB);
    PG8_WAIT_V(6); PG8_BAR;
    for (;;) {
        const bool has_next = S.next(ui + 1, nxt);
        const char* nA = has_next ? (const char*)g.A + (size_t)nxt.pm * tstep : cA; const char* nB = has_next ? (const char*)g.Bt + (size_t)nxt.pn * tstep : cB;
#pragma unroll 1
        for (int t = 0; t < nt; t += 2) {
            const bool last = (t == nt - 2);
            const char* a1 = cA + (size_t)(t + 1) * kstep;
            const char* a2 = last ? nA : cA + (size_t)(t + 2) * kstep; const char* b2 = last ? nB : cB + (size_t)(t + 2) * kstep;
            const char* a3 = a2 + kstep; const char* b3 = b2 + kstep;
            PG8_LDB(B0, 0, 0); PG8_LDB(B1, 0, 1); PG8_SCHED; PG8_LDA(At, 0, 0); PG8_STAGE(PG8_SA(1, 1), a1 + hstep, voffA);
            PG8_WAIT_V(8); PG8_WAIT_L(0); PG8_BAR; PG8_MMA(0, 0, At, B0); PG8_MMA(0, 1, At, B1); PG8_BAR; PG8_SCHED;
            PG8_LDA(At, 0, 1); PG8_STAGE(PG8_SB(0, 0), b2, voffB); PG8_STAGE(PG8_SB(0, 1), b2 + hstep, voffB); PG8_STAGE(PG8_SA(0, 0), a2, voffA);
            PG8_WAIT_V(8); PG8_WAIT_L(0); PG8_BAR; PG8_MMA(1, 0, At, B0); PG8_MMA(1, 1, At, B1); PG8_BAR; PG8_SCHED;
            PG8_LDB(B0, 1, 0); PG8_LDB(B1, 1, 1); PG8_SCHED; PG8_LDA(At, 1, 0); PG8_STAGE(PG8_SA(0, 1), a2 + hstep, voffA);
            PG8_WAIT_V(8); PG8_WAIT_L(0); PG8_BAR; PG8_MMA(0, 0, At, B0); PG8_MMA(0, 1, At, B1); PG8_BAR; PG8_SCHED;
            PG8_LDA(At, 1, 1); PG8_STAGE(PG8_SB(1, 0), b3, voffB); PG8_STAGE(PG8_SB(1, 1), b3 + hstep, voffB); PG8_STAGE(PG8_SA(1, 0), a3, voffA);
            PG8_WAIT_V(8); PG8_WAIT_L(0); PG8_BAR; PG8_MMA(1, 0, At, B0); PG8_MMA(1, 1, At, B1); PG8_BAR; PG8_SCHED;
        }
        if constexpr (ALIGN_EPI) { if (wr == 0) PG8_BAR; }
        { int fr_ = fr, fq_ = fq; asm volatile("" : "+v"(fr_), "+v"(fq_));
          E(acc, cur, wr, wc, fr_, fq_); }
        if (!has_next) break;
#pragma unroll
        for (int a = 0; a < 2; ++a)
#pragma unroll
            for (int b = 0; b < 2; ++b)
#pragma unroll
                for (int m = 0; m < 4; ++m)
#pragma unroll
                    for (int n = 0; n < 2; ++n) acc[a][b][m][n] = (f32x4){0.f, 0.f, 0.f, 0.f};
        cur = nxt; cA = nA; cB = nB; ++ui;
        if constexpr (ALIGN_EPI) { if (wr == 1) PG8_BAR; }
    }
    PG8_WAIT_V(0);
    if constexpr (!ALIGN_EPI) { if (wr == 0) PG8_BAR; }
    PG8_BAR;
#undef PG8_SA
#undef PG8_SB
#undef PG8_STAGE
#undef PG8_LDA
#undef PG8_LDB
#undef PG8_MMA
#undef PG8_WAIT_V
#undef PG8_WAIT_L
#undef PG8_BAR
#undef PG8_SCHED
}

struct EpiOut {
    h16* Y; float* ssy;
    __device__ __forceinline__ void operator()(const f32x4 (&acc)[2][2][4][2], const Unit& u, int wr, int wc, int fr, int fq) const {
        const int row0 = u.pm * BM + wr * 64 + fr, col0 = u.pn * BM + wc * 32 + 8 * fq;
#pragma unroll
        for (int ai = 0; ai < 2; ++ai)
#pragma unroll
            for (int m = 0; m < 4; ++m) { const int row = row0 + ai * HALF + m * 16; h16* rowp = Y + (size_t)row * DM + col0; float s = 0.f;
#pragma unroll
                for (int bj = 0; bj < 2; ++bj) { const f32x4 v0 = acc[ai][bj][m][0], v1 = acc[ai][bj][m][1];
                    s += (v0[0] * v0[0] + v0[1] * v0[1]) + (v0[2] * v0[2] + v0[3] * v0[3]) + (v1[0] * v1[0] + v1[1] * v1[1]) + (v1[2] * v1[2] + v1[3] * v1[3]);
                    *(u32x4*)(rowp + bj * HALF) = pk_h8(v0, v1); }
                s += __shfl_xor(s, 16); s += __shfl_xor(s, 32);
                if (fq == 0) atomicAdd(ssy + row, s); }
    }
};

__device__ __forceinline__ float silu_f(float v) { return v * __builtin_amdgcn_rcpf(1.0f + __builtin_amdgcn_exp2f(-1.4426950408889634f * v)); }
struct EpiProj {
    h16 *U, *V, *ZA, *ZB, *CQ, *KV, *KIDX; float *CKVR, *WIDX, *ssq, *sskv; const float* rope;
    __device__ __forceinline__ void operator()(const f32x4 (&acc)[2][2][4][2], const Unit& u, int wr, int wc, int fr, int fq) const {
        const int row0 = u.pm * BM + wr * 64 + fr, pn = u.pn;
        if (pn < 8) {
            h16* base = (pn < 2 ? U : pn < 4 ? V : pn < 6 ? ZA : ZB) + (pn & 1) * 256 + wc * 32 + 8 * fq;
            const bool is_gelu = pn < 4;
#pragma unroll
            for (int ai = 0; ai < 2; ++ai)
#pragma unroll
                for (int m = 0; m < 4; ++m) { h16* rowp = base + (size_t)(row0 + ai * HALF + m * 16) * GW;
#pragma unroll
                    for (int bj = 0; bj < 2; ++bj) { f32x4 v0 = acc[ai][bj][m][0], v1 = acc[ai][bj][m][1];
                        if (is_gelu) { const f32x2 a = gelu_pk((f32x2){v0[0], v0[1]}), b = gelu_pk((f32x2){v0[2], v0[3]}), c = gelu_pk((f32x2){v1[0], v1[1]}), d = gelu_pk((f32x2){v1[2], v1[3]});
                            v0 = (f32x4){a.x, a.y, b.x, b.y}; v1 = (f32x4){c.x, c.y, d.x, d.y}; }
                        else { v0 = (f32x4){silu_f(v0[0]), silu_f(v0[1]), silu_f(v0[2]), silu_f(v0[3])}; v1 = (f32x4){silu_f(v1[0]), silu_f(v1[1]), silu_f(v1[2]), silu_f(v1[3])}; }
                        *(u32x4*)(rowp + bj * HALF) = pk_h8(v0, v1); } }
        } else if (pn == 8) {
            const int col0 = wc * 32 + 8 * fq;
#pragma unroll
            for (int ai = 0; ai < 2; ++ai)
#pragma unroll
                for (int m = 0; m < 4; ++m) { const int row = row0 + ai * HALF + m * 16; h16* rowp = CQ + (size_t)row * QR + col0; float s = 0.f;
#pragma unroll
                    for (int bj = 0; bj < 2; ++bj) { const f32x4 v0 = acc[ai][bj][m][0], v1 = acc[ai][bj][m][1];
                        s += (v0[0] * v0[0] + v0[1] * v0[1]) + (v0[2] * v0[2] + v0[3] * v0[3]) + (v1[0] * v1[0] + v1[1] * v1[1]) + (v1[2] * v1[2] + v1[3] * v1[3]);
                        *(u32x4*)(rowp + bj * HALF) = pk_h8(v0, v1); }
                    s += __shfl_xor(s, 16); s += __shfl_xor(s, 32);
                    if (fq == 0) atomicAdd(ssq + row, s); }
        } else {
#pragma unroll
            for (int ai = 0; ai < 2; ++ai)
#pragma unroll
                for (int m = 0; m < 4; ++m) { const int row = row0 + ai * HALF + m * 16;
                    { const f32x4 v0 = acc[ai][0][m][0], v1 = acc[ai][0][m][1];
                        float s = (v0[0] * v0[0] + v0[1] * v0[1]) + (v0[2] * v0[2] + v0[3] * v0[3]) + (v1[0] * v1[0] + v1[1] * v1[1]) + (v1[2] * v1[2] + v1[3] * v1[3]);
                        float* p = CKVR + (size_t)row * CKV + wc * 32 + 8 * fq; *(f32x4*)p = v0; *(f32x4*)(p + 4) = v1;
                        s += __shfl_xor(s, 16); s += __shfl_xor(s, 32);
                        if (fq == 0) atomicAdd(sskv + row, s); }
                    const f32x4 x1 = acc[ai][1][m][0], x2 = acc[ai][1][m][1];
                    if (wc == 0) {
                        const int pos = row & (SEQ - 1); const float* rp = rope + (size_t)pos * 32 + 8 * fq;
                        const f32x4 r0 = *(const f32x4*)rp, r1 = *(const f32x4*)(rp + 4);
                        const float o1a = x1[0] * r0[0] - x2[0] * r0[1], o2a = x2[0] * r0[0] + x1[0] * r0[1];
                        const float o1b = x1[1] * r0[2] - x2[1] * r0[3], o2b = x2[1] * r0[2] + x1[1] * r0[3];
                        const float o1c = x1[2] * r1[0] - x2[2] * r1[1], o2c = x2[2] * r1[0] + x1[2] * r1[1];
                        const float o1d = x1[3] * r1[2] - x2[3] * r1[3], o2d = x2[3] * r1[2] + x1[3] * r1[3];
                        h16* p = KV + (size_t)row * KVD + CKV + 4 * fq;
                        typedef unsigned u32x2 __attribute__((ext_vector_type(2)));
                        *(u32x2*)p = (u32x2){pk_h2(o1a, o1b), pk_h2(o1c, o1d)}; *(u32x2*)(p + 16) = (u32x2){pk_h2(o2a, o2b), pk_h2(o2c, o2d)};
                    } else if (wc < 3) {
                        *(u32x4*)(KIDX + (size_t)row * IDXD + (wc - 1) * 32 + 8 * fq) = pk_h8(x1, x2);
                    } else if (fq == 0) {
                        float* p = WIDX + (size_t)row * NH; *(f32x4*)p = x1 * 0.044194173824159216f; *(f32x4*)(p + 4) = x2 * 0.044194173824159216f;
                    } }
        }
    }
};

struct EpiQ {
    h16 *QA, *QIDX; const float* ssq; const float* rope;
    template <int RS, int BS>
    __device__ __forceinline__ void plain(const f32x4 (&acc)[2][2][4][2], h16* base, int row0) const {
#pragma unroll
        for (int ai = 0; ai < 2; ++ai)
#pragma unroll
            for (int m = 0; m < 4; ++m) { const int row = row0 + ai * HALF + m * 16; const float rstd = rsqrtf(ssq[row] * (1.f / QR) + EPS);
                h16* rowp = base + (size_t)row * RS;
#pragma unroll
                for (int bj = 0; bj < 2; ++bj) *(u32x4*)(rowp + bj * BS) = pk_h8(acc[ai][bj][m][0] * rstd, acc[ai][bj][m][1] * rstd);
                asm volatile("" ::: "memory"); }
    }
    __device__ __forceinline__ void operator()(const f32x4 (&acc)[2][2][4][2], const Unit& u, int wr, int wc, int fr, int fq) const {
        const int row0 = u.pm * BM + wr * 64 + fr, pn = u.pn;
        if (pn < 4) plain<NH * KVD, KVD>(acc, QA + (2 * pn) * KVD + wc * 32 + 8 * fq, row0);
        else if (pn < 6) plain<512, HALF>(acc, QIDX + (pn - 4) * 256 + wc * 32 + 8 * fq, row0);
        else {
#pragma unroll
            for (int ai = 0; ai < 2; ++ai)
#pragma unroll
                for (int m = 0; m < 4; ++m) { const int row = row0 + ai * HALF + m * 16; const float rstd = rsqrtf(ssq[row] * (1.f / QR) + EPS);
                    const int pos = row & (SEQ - 1); const float* rp = rope + (size_t)pos * 32 + 8 * fq;
                    const f32x4 r0 = *(const f32x4*)rp * rstd, r1 = *(const f32x4*)(rp + 4) * rstd;
#pragma unroll
                    for (int bj = 0; bj < 2; ++bj) { const f32x4 v0 = acc[ai][bj][m][0], v1 = acc[ai][bj][m][1];
                        const float o1a = v0[0] * r0[0] - v1[0] * r0[1], o2a = v1[0] * r0[0] + v0[0] * r0[1];
                        const float o1b = v0[1] * r0[2] - v1[1] * r0[3], o2b = v1[1] * r0[2] + v0[1] * r0[3];
                        const float o1c = v0[2] * r1[0] - v1[2] * r1[1], o2c = v1[2] * r1[0] + v0[2] * r1[1];
                        const float o1d = v0[3] * r1[2] - v1[3] * r1[3], o2d = v1[3] * r1[2] + v0[3] * r1[3];
                        h16* p = QA + (size_t)row * (NH * KVD) + (4 * bj + wc) * KVD + CKV + 4 * fq;
                        typedef unsigned u32x2 __attribute__((ext_vector_type(2)));
                        *(u32x2*)p = (u32x2){pk_h2(o1a, o1b), pk_h2(o1c, o1d)}; *(u32x2*)(p + 16) = (u32x2){pk_h2(o2a, o2b), pk_h2(o2c, o2d)}; }
                    asm volatile("" ::: "memory"); }
        }
    }
};
}

constexpr int NTHREADS = 512;
constexpr int LDS_BYTES = 147456;


__device__ __forceinline__ void ckvnorm_phase(const Args& a, const int g_wid) {
    int tid_ = TID(); asm volatile("" : "+v"(tid_));
    unsigned char* ws = a.ws; const float* CKVR = (const float*)(ws + WS_CKVR); const float* sskv = (const float*)(ws + WS_SSKV); h16* KV = (h16*)(ws + WS_KV);
    { const h16* KIDX = (const h16*)(ws + WS_KIDX); unsigned* kmax = (unsigned*)(ws + WS_KMAX);
      for (int tok = blockIdx.x * blockDim.x + tid_; tok < T; tok += gridDim.x * blockDim.x) { float s = 0.f;
        for (int e = 0; e < 8; ++e) { const h16x8 v = *(const h16x8*)(KIDX + (size_t)tok * IDXD + 8 * e); for (int k = 0; k < 8; ++k) s += (float)v[k] * (float)v[k]; }
        for (int o = 1; o < 64; o <<= 1) s = fmaxf(s, __shfl_xor(s, o));
        if ((tid_ & 63) == 0) atomicMax(kmax + tok / SEQ, __float_as_uint(s)); } }
    for (int i = blockIdx.x * blockDim.x + tid_; i < T * 16; i += gridDim.x * blockDim.x) {
        const int tok = i >> 4, c = (i & 15) * 8; const float rstd = rsqrtf(sskv[tok] * (1.f / CKV) + EPS);
        const f32x4 v0 = *(const f32x4*)(CKVR + (size_t)tok * CKV + c), v1 = *(const f32x4*)(CKVR + (size_t)tok * CKV + c + 4);
        const f32x4 g0 = *(const f32x4*)(a.kvn_g + c), g1 = *(const f32x4*)(a.kvn_g + c + 4);
        *(pg8::u32x4*)(KV + (size_t)tok * KVD + c) = pg8::pk_h8(v0 * rstd * g0, v1 * rstd * g1);
    }
}


namespace p3 {
#define LAS __attribute__((address_space(3)))
typedef float f32x16 __attribute__((ext_vector_type(16)));
typedef short s16x4 __attribute__((ext_vector_type(4)));
typedef unsigned u32x4 __attribute__((ext_vector_type(4)));
typedef unsigned u32x2 __attribute__((ext_vector_type(2)));
constexpr int CC = 96;
constexpr int L_SEL = 0;
constexpr int L_META = 16384;
constexpr int L_WQ = L_META + 1024;
constexpr int L_QN = L_WQ + 1024;
constexpr int L_MISC = L_QN + 1024;
constexpr int L_QS = 20480, QS_STRIDE = 1040;
constexpr int L_HIST = L_QS + 32 * QS_STRIDE;
constexpr int L_CAND = L_HIST + 65536;
constexpr int L_VBUF = 20480;
constexpr int L_OLAT = L_VBUF + 65536, OL_STRIDE = 2064;
constexpr int L_END = L_OLAT + 32 * OL_STRIDE;
static_assert(L_CAND + 32 * CC * 8 <= L_END, "lds map");

__device__ __forceinline__ float med3(float a, float b, float c) { return __builtin_amdgcn_fmed3f(a, b, c); }

constexpr unsigned KBASE = 0x3C000000u >> 7;
constexpr unsigned K1 = (512u << 10) - KBASE, K2 = (512u << 10) - 1u + KBASE;
__device__ __forceinline__ float relu_i(float x) { const int b = __builtin_bit_cast(int, x); return __builtin_bit_cast(float, b > 0 ? b : 0); }
#define P3_QRD(dst, off) asm volatile("ds_read_b128 %0, %1 offset:%2" : "=v"(dst) : "v"(qaddr), "i"(off))
template <int PASS>
__device__ __forceinline__ void index_pass(LAS unsigned char* lds, const h16* kb, int npair, int wid, int lane, float* scache) {
    asm volatile("" : "+v"(lane));
    const int r = lane & 31, hh = lane >> 5;
    float w[8];
    { const f32x4 w0 = *(const LAS f32x4*)(lds + L_WQ + r * 32), w1 = *(const LAS f32x4*)(lds + L_WQ + r * 32 + 16);
      w[0] = w0[0]; w[1] = w0[1]; w[2] = w0[2]; w[3] = w0[3]; w[4] = w1[0]; w[5] = w1[1]; w[6] = w1[2]; w[7] = w1[3]; }
    const float sp = *(const LAS float*)(lds + L_META + r * 4), sn = *(const LAS float*)(lds + L_META + 128 + r * 4);
    unsigned tlo = 0u, thi = 0u;
    if (PASS >= 2) { tlo = *(const LAS unsigned*)(lds + L_META + 256 + r * 4); thi = *(const LAS unsigned*)(lds + L_META + 768 + r * 4); }
    const unsigned qaddr = (unsigned)(uintptr_t)(lds + L_QS + r * QS_STRIDE + hh * 16);
    LAS unsigned char* hist = lds + L_HIST + r * 2048;
    LAS unsigned* selcnt = (LAS unsigned*)(lds + L_META + 512 + r * 4);
    LAS unsigned* candcnt = (LAS unsigned*)(lds + L_META + 640 + r * 4);
    LAS unsigned short* sel = (LAS unsigned short*)(lds + L_SEL) + r * 256;
    LAS u32x2* cand = (LAS u32x2*)(lds + L_CAND) + r * CC;
    h16x8 a0[4], an[4];
    int p = wid;
    if (p < npair) { const h16* kp = kb + (size_t)(p * 32 + r) * IDXD + hh * 8; const int p2 = (p + 8 < npair) ? p + 8 : p; const h16* kq = kb + (size_t)(p2 * 32 + r) * IDXD + hh * 8;
#pragma unroll
        for (int ks = 0; ks < 4; ++ks) { a0[ks] = *(const h16x8*)(kp + 16 * ks); an[ks] = *(const h16x8*)(kq + 16 * ks); } }
    for (; p < npair; p += 8) {
        f32x16 sc0, cA, cB;
#pragma unroll
        for (int i = 0; i < 16; ++i) { sc0[i] = 0.f; cA[i] = 0.f; }
        h16x8 bA[4], bB[4];
        P3_QRD(bA[0], 0); P3_QRD(bA[1], 32); P3_QRD(bA[2], 64); P3_QRD(bA[3], 96);
        P3_QRD(bB[0], 128); P3_QRD(bB[1], 160); P3_QRD(bB[2], 192); P3_QRD(bB[3], 224);
        asm volatile("s_waitcnt lgkmcnt(0)" ::: "memory"); __builtin_amdgcn_sched_barrier(0);
#pragma unroll
        for (int ks = 0; ks < 4; ++ks) cA = __builtin_amdgcn_mfma_f32_32x32x16_f16(a0[ks], bA[ks], cA, 0, 0, 0);
#define P3_R(h, cC, cN, bufC, bufN) do { \
            if ((h) < 7) { _Pragma("unroll") for (int i = 0; i < 16; ++i) cN[i] = 0.f; \
                _Pragma("unroll") for (int ks = 0; ks < 4; ++ks) cN = __builtin_amdgcn_mfma_f32_32x32x16_f16(a0[ks], bufN[ks], cN, 0, 0, 0); } \
            if ((h) < 6) { P3_QRD(bufC[0], ((h) + 2) * 128); P3_QRD(bufC[1], ((h) + 2) * 128 + 32); P3_QRD(bufC[2], ((h) + 2) * 128 + 64); P3_QRD(bufC[3], ((h) + 2) * 128 + 96); } \
            if ((h) == 7) { const int pn_ = (p + 16 < npair) ? p + 16 : p; const h16* kp = kb + (size_t)(pn_ * 32 + r) * IDXD + hh * 8; \
                _Pragma("unroll") for (int ks = 0; ks < 4; ++ks) { a0[ks] = an[ks]; an[ks] = *(const h16x8*)(kp + 16 * ks); } } \
            if (PASS == 0 && REP_PHASE == 35) { asm volatile("" :: "v"(cC)); } else \
            _Pragma("unroll") for (int i = 0; i < 16; ++i) { const float rl_ = relu_i(cC[i]); asm("v_fmac_f32 %0, %1, %2" : "+v"(sc0[i]) : "v"(w[h]), "v"(rl_)); }     \
            asm volatile("" : "+v"(sc0));     \
            if ((h) < 6) asm volatile("s_waitcnt lgkmcnt(0)" ::: "memory"); \
            __builtin_amdgcn_sched_barrier(0); } while (0)
        P3_R(0, cA, cB, bA, bB); P3_R(1, cB, cA, bB, bA); P3_R(2, cA, cB, bA, bB); P3_R(3, cB, cA, bB, bA);
        P3_R(4, cA, cB, bA, bB); P3_R(5, cB, cA, bB, bA); P3_R(6, cA, cB, bA, bB); P3_R(7, cB, cA, bB, bA);
#undef P3_R
        { float* sp_ = scache + ((size_t)(p * 32 + 4 * hh) * 32 + r);
#pragma unroll
          for (int i = 0; i < 16; ++i) sp_[((i & 3) + 8 * (i >> 2)) * 32] = sc0[i]; }
        unsigned ckv[16]; unsigned ns = 0, nc = 0;
        if (PASS == 0 && REP_PHASE != 34) { asm volatile("" :: "v"(sc0)); } else
#pragma unroll
        for (int i = 0; i < 16; ++i) {
            const float sc = sc0[i]; const int mask = __builtin_bit_cast(int, sc) >> 31;
            const float scl = __builtin_bit_cast(float, (mask & __builtin_bit_cast(int, sn)) | (~mask & __builtin_bit_cast(int, sp)));
            const float v = __builtin_fmaf(__builtin_fabsf(sc), scl, 0.0078125f);
            const unsigned ck = (((__float_as_uint(v) >> 7) - KBASE) ^ (unsigned)mask) + (512u << 10);
            if (PASS == 0) { asm volatile("" :: "v"(ck)); }
            else if (PASS == 1) { __hip_atomic_fetch_add((LAS unsigned*)(hist + ((ck >> 8) & 0x7fcu)), (unsigned)((mask & 1) | (~mask & 65536)), __ATOMIC_RELAXED, __HIP_MEMORY_SCOPE_WORKGROUP); }
            else if (PASS == 2) { if ((ck >> 10) == tlo) { __hip_atomic_fetch_add((LAS unsigned*)(hist + ((ck << 2) & 0x7fcu)), (ck & 512u) ? 65536u : 1u, __ATOMIC_RELAXED, __HIP_MEMORY_SCOPE_WORKGROUP); } }
            else { ns = ns + ns + ((ck >= thi) ? 1u : 0u); nc = nc + nc + ((ck >= tlo) ? 1u : 0u); if (ck >= tlo && ck < thi) ckv[i] = __float_as_uint(sc); }
            if ((i & 3) == 3) __builtin_amdgcn_sched_barrier(0);
        }
        if (PASS == 3) {
            if (nc != 0u) {
                unsigned cm = nc & ~ns;
                const unsigned nsel = __builtin_popcount(ns);
                unsigned ps = nsel ? __hip_atomic_fetch_add(selcnt, nsel, __ATOMIC_RELAXED, __HIP_MEMORY_SCOPE_WORKGROUP) : 0u;
                while (ns) { const int bit = 31 - __builtin_clz(ns), i = 15 - bit; ns &= ~(1u << bit);
                    if (ps < 256u) sel[ps] = (unsigned short)(p * 32 + (i & 3) + 8 * (i >> 2) + 4 * hh); ++ps; }
                if (cm) {
                    unsigned pc = __hip_atomic_fetch_add(candcnt, (unsigned)__builtin_popcount(cm), __ATOMIC_RELAXED, __HIP_MEMORY_SCOPE_WORKGROUP);
#pragma unroll
                    for (int i = 0; i < 16; ++i) if (cm & (1u << (15 - i))) { if (pc < (unsigned)CC) cand[pc] = (u32x2){ckv[i], (unsigned)(p * 32 + (i & 3) + 8 * (i >> 2) + 4 * hh)}; ++pc; }
                }
            }
        }
    }
}
#undef P3_QRD

__device__ __forceinline__ void find_thr(LAS unsigned char* lds, int q, unsigned need, int lane, int& tbin, unsigned& nabove, unsigned& nin) {
    const LAS u32x4* hq = (const LAS u32x4*)(lds + L_HIST + q * 2048 + lane * 32); const u32x4 wa = hq[0], wb = hq[1];
    const unsigned wv[8] = {wa[0], wa[1], wa[2], wa[3], wb[0], wb[1], wb[2], wb[3]}; unsigned totH = 0, totL = 0;
#pragma unroll
    for (int e = 0; e < 8; ++e) { totH += wv[e] >> 16; totL += wv[e] & 0xffffu; }
    unsigned sH = totH, sL = totL;
#pragma unroll
    for (int o = 1; o < 64; o <<= 1) { const unsigned t = __shfl_down(sH, o), u = __shfl_down(sL, o); if (lane + o < 64) { sH += t; sL += u; } }
    const unsigned allH = __shfl(sH, 0);
    const bool inH = allH >= need;
    const unsigned nd = inH ? need : need - allH, base = inH ? 0u : allH, sfx = inH ? sH : sL, tot = inH ? totH : totL;
    const unsigned long long bal = __ballot(sfx >= nd);
    const int L = bal ? 63 - __builtin_clzll(bal) : 0;
    unsigned above = base + sfx - tot, nab = above, ni = 0; bool found = false; int tb = 8 * lane;
#pragma unroll
    for (int e = 7; e >= 0; --e) { const unsigned c = inH ? (wv[e] >> 16) : (wv[e] & 0xffffu);
        if (!found && above + c >= need) { found = true; tb = 8 * lane + e; nab = above; ni = c; }
        if (!found) above += c; }
    tbin = __shfl(tb, L) + (inH ? 512 : 0); nabove = __shfl(nab, L); nin = __shfl(ni, L);
}

__device__ __forceinline__ unsigned ck_of(float sc, float sp, float sn) {
    const int mask = __builtin_bit_cast(int, sc) >> 31;
    const float scl = __builtin_bit_cast(float, (mask & __builtin_bit_cast(int, sn)) | (~mask & __builtin_bit_cast(int, sp)));
    const float v = __builtin_fmaf(__builtin_fabsf(sc), scl, 0.0078125f);
    return (((__float_as_uint(v) >> 7) - KBASE) ^ (unsigned)mask) + (512u << 10);
}
template <int MODE>
__device__ __forceinline__ void scan_scores(LAS unsigned char* lds, const float* scache, int N, int wid, int lane) {
    asm volatile("" : "+v"(lane));
    const int q4 = (lane & 7) * 4, kr = lane >> 3;
    float sp[4], sn[4]; unsigned tlo[4], thi[4];
#pragma unroll
    for (int j = 0; j < 4; ++j) { sp[j] = ((const LAS float*)(lds + L_META))[q4 + j]; sn[j] = ((const LAS float*)(lds + L_META + 128))[q4 + j];
        tlo[j] = ((const LAS unsigned*)(lds + L_META + 256))[q4 + j]; thi[j] = ((const LAS unsigned*)(lds + L_META + 768))[q4 + j]; }
    for (int k0 = wid * 8; k0 < N; k0 += 64) {
        const int key = k0 + kr;
        const f32x4 s4 = *(const f32x4*)(scache + (size_t)key * 32 + q4);
#pragma unroll
        for (int j = 0; j < 4; ++j) {
            const float sc = s4[j]; const unsigned ck = ck_of(sc, sp[j], sn[j]);
            if (MODE == 2) { if ((ck >> 10) == tlo[j]) __hip_atomic_fetch_add((LAS unsigned*)(lds + L_HIST + (q4 + j) * 2048 + ((ck << 2) & 0x7fcu)), (ck & 512u) ? 65536u : 1u, __ATOMIC_RELAXED, __HIP_MEMORY_SCOPE_WORKGROUP); }
            else if (ck >= tlo[j]) {
                if (ck >= thi[j]) { const unsigned ps = __hip_atomic_fetch_add((LAS unsigned*)(lds + L_META + 512 + (q4 + j) * 4), 1u, __ATOMIC_RELAXED, __HIP_MEMORY_SCOPE_WORKGROUP); if (ps < 256u) ((LAS unsigned short*)(lds + L_SEL))[(q4 + j) * 256 + ps] = (unsigned short)key; }
                else { const unsigned pc = __hip_atomic_fetch_add((LAS unsigned*)(lds + L_META + 640 + (q4 + j) * 4), 1u, __ATOMIC_RELAXED, __HIP_MEMORY_SCOPE_WORKGROUP); if (pc < (unsigned)CC) ((LAS u32x2*)(lds + L_CAND))[(q4 + j) * CC + pc] = (u32x2){__float_as_uint(sc), (unsigned)key}; }
            }
        }
    }
}

template <int AMODE = 0>
__device__ __forceinline__ void attn_query(LAS unsigned char* lds, const h16* qa, const h16* kvb, int qi, int cnt, int wid, int lane) {
    asm volatile("" : "+v"(lane));
    const int c15 = lane & 15, g = lane >> 4, k7 = c15 & 7;
    h16x8 qb[5];
#pragma unroll
    for (int ks = 0; ks < 5; ++ks) { h16x8 z; for (int e = 0; e < 8; ++e) z[e] = (h16)0.f; qb[ks] = c15 < 8 ? *(const h16x8*)(qa + c15 * KVD + 32 * ks + 8 * g) : z; }
    f32x4 o[8];
#pragma unroll
    for (int ct = 0; ct < 8; ++ct) o[ct] = (f32x4){0.f, 0.f, 0.f, 0.f};
    float m_run = -INFINITY, l_part = 0.f;
    const LAS unsigned short* sel = (const LAS unsigned short*)(lds + L_SEL) + qi * 256;
    LAS unsigned char* vb = lds + L_VBUF + wid * 8192;
    LAS unsigned char* wrow = vb + c15 * 256;
    const int kt = 4 * g + (c15 >> 2), pp = c15 & 3;
    const unsigned trbase = (unsigned)(uintptr_t)(vb + kt * 256 + 16 * (pp >> 1) + 8 * (pp & 1));
    const int kt7 = kt & 7;
    const int nch = cnt >> 5;
    constexpr float SC = 0.10206207261596577f * 1.4426950408889634f;
    h16x8 n0[5], n1[5];
    { const int i0 = sel[c15], i1 = sel[16 + c15];
      const h16* r0 = kvb + (size_t)i0 * KVD + 8 * g; const h16* r1 = kvb + (size_t)i1 * KVD + 8 * g;
#pragma unroll
      for (int ks = 0; ks < 5; ++ks) { n0[ks] = *(const h16x8*)(r0 + 32 * ks); n1[ks] = *(const h16x8*)(r1 + 32 * ks); } }
    for (int c = 0; c < nch; ++c) {
        h16x8 a0[5], a1[5];
#pragma unroll
        for (int ks = 0; ks < 5; ++ks) { a0[ks] = n0[ks]; a1[ks] = n1[ks]; }
        if (AMODE != 1) { const int cn = (c + 1 < nch) ? c + 1 : c; const int i0 = sel[32 * cn + c15], i1 = sel[32 * cn + 16 + c15];
          const h16* r0 = kvb + (size_t)i0 * KVD + 8 * g; const h16* r1 = kvb + (size_t)i1 * KVD + 8 * g;
#pragma unroll
          for (int ks = 0; ks < 5; ++ks) { n0[ks] = *(const h16x8*)(r0 + 32 * ks); n1[ks] = *(const h16x8*)(r1 + 32 * ks); } }
        if (AMODE == 2) {
#pragma unroll
          for (int ks = 0; ks < 5; ++ks) { asm volatile("" :: "v"(a0[ks]), "v"(a1[ks])); }
          continue; }
#pragma unroll
        for (int ks = 0; ks < 4; ++ks) { const int ch = ((4 * ks + g) ^ (2 * k7)) << 4; *(LAS h16x8*)(wrow + ch) = a0[ks]; *(LAS h16x8*)(wrow + 4096 + ch) = a1[ks]; }
        f32x4 s0 = (f32x4){0.f, 0.f, 0.f, 0.f}, s1 = (f32x4){0.f, 0.f, 0.f, 0.f};
#pragma unroll
        for (int ks = 0; ks < 5; ++ks) { s0 = __builtin_amdgcn_mfma_f32_16x16x32_f16(a0[ks], qb[ks], s0, 0, 0, 0); s1 = __builtin_amdgcn_mfma_f32_16x16x32_f16(a1[ks], qb[ks], s1, 0, 0, 0); }
        s0 = s0 * SC; s1 = s1 * SC;
        float mx = fmaxf(fmaxf(fmaxf(s0[0], s0[1]), fmaxf(s0[2], s0[3])), fmaxf(fmaxf(s1[0], s1[1]), fmaxf(s1[2], s1[3])));
        mx = fmaxf(mx, __shfl_xor(mx, 16)); mx = fmaxf(mx, __shfl_xor(mx, 32));
        const float mn = fmaxf(m_run, mx), alpha = __builtin_amdgcn_exp2f(m_run - mn);
        f32x4 p0, p1;
#pragma unroll
        for (int e = 0; e < 4; ++e) { p0[e] = __builtin_amdgcn_exp2f(s0[e] - mn); p1[e] = __builtin_amdgcn_exp2f(s1[e] - mn); }
        l_part = l_part * alpha + ((p0[0] + p0[1]) + (p0[2] + p0[3])) + ((p1[0] + p1[1]) + (p1[2] + p1[3]));
        m_run = mn;
#pragma unroll
        for (int ct = 0; ct < 8; ++ct) o[ct] = o[ct] * alpha;
        h16x8 pb; pb[0] = (h16)p0[0]; pb[1] = (h16)p0[1]; pb[2] = (h16)p0[2]; pb[3] = (h16)p0[3]; pb[4] = (h16)p1[0]; pb[5] = (h16)p1[1]; pb[6] = (h16)p1[2]; pb[7] = (h16)p1[3];
        s16x4 lo[8], hi[8];
#pragma unroll
        for (int ct = 0; ct < 8; ++ct) { const unsigned ad = trbase + (unsigned)((ct ^ kt7) << 5);
            asm volatile("ds_read_b64_tr_b16 %0, %1" : "=&v"(lo[ct]) : "v"(ad) : "memory");
            asm volatile("ds_read_b64_tr_b16 %0, %1 offset:4096" : "=&v"(hi[ct]) : "v"(ad) : "memory"); }
        asm volatile("s_waitcnt lgkmcnt(0)" ::: "memory"); __builtin_amdgcn_sched_barrier(0);
#pragma unroll
        for (int ct = 0; ct < 8; ++ct) { const s16x4 l4 = lo[ct], h4 = hi[ct];
            typedef short s16x8 __attribute__((ext_vector_type(8)));
            const s16x8 va = (s16x8){l4[0], l4[1], l4[2], l4[3], h4[0], h4[1], h4[2], h4[3]};
            o[ct] = __builtin_amdgcn_mfma_f32_16x16x32_f16(__builtin_bit_cast(h16x8, va), pb, o[ct], 0, 0, 0); }
    }
    float l = l_part; l += __shfl_xor(l, 16); l += __shfl_xor(l, 32);
    const float inv = 1.0f / l;
    if (c15 < 8) {
        LAS unsigned char* op = lds + L_OLAT + qi * OL_STRIDE + c15 * 256 + 8 * g;
#pragma unroll
        for (int ct = 0; ct < 8; ++ct) { h16x4 v; v[0] = (h16)(o[ct][0] * inv); v[1] = (h16)(o[ct][1] * inv); v[2] = (h16)(o[ct][2] * inv); v[3] = (h16)(o[ct][3] * inv);
            *(LAS h16x4*)(op + 32 * ct) = v; }
    }
}

template <int REPSEL = 1, int REPATT = 1>
__device__ __forceinline__ void phase(LAS unsigned char* lds, unsigned char* ws, size_t qoff, const int g_wid) {
    const int wid = __builtin_amdgcn_readfirstlane(threadIdx.x >> 6);
    const h16* QIDX = (const h16*)(ws + WS_QIDX); const h16* KIDX = (const h16*)(ws + WS_KIDX); const float* WIDX = (const float*)(ws + WS_WIDX);
    const h16* QA = (const h16*)(ws + WS_QA); const h16* KV = (const h16*)(ws + WS_KV); const h16* WuvT = (const h16*)(ws + WS_WUVT);
    const h16* ZB = (const h16*)(ws + WS_ZB); h16* A2 = (h16*)(ws + WS_A2);
    unsigned* qctr = (unsigned*)(ws + WS_QUEUE + qoff); const unsigned* kmaxp = (const unsigned*)(ws + WS_KMAX);
    const int queue = blockIdx.x & 7, b = queue >> 1;
    LAS int* misc = (LAS int*)(lds + L_MISC);
    for (;;) {
        if (TID() == 0) misc[0] = (int)atomicAdd(qctr + queue * 64, 1u);
        __syncthreads();
        const int j = misc[0];
        if (j >= 128) break;
        int tid = TID(); asm volatile("" : "+v"(tid));
        const int lane = tid & 63;
        const int qt = 255 - 2 * j - (queue & 1), q0 = qt * 32, tok0 = b * SEQ + q0, N = ((q0 >> 6) + 1) * 64;
        for (int rep_ = 0; rep_ < REPSEL; ++rep_) {
        if (rep_) __syncthreads();
        for (int i = tid; i < 1024; i += NTHREADS) ((LAS u32x4*)(lds + L_SEL))[i] = (u32x4){0u, 0u, 0u, 0u};
        if (N <= TOPK) {
            __syncthreads();
            for (int i = tid; i < 32 * 256; i += NTHREADS) { const int jj = i & 255; if (jj < N) ((LAS unsigned short*)(lds + L_SEL))[i] = (unsigned short)jj; }
        } else {
            { const int q = tid >> 4, part = tid & 15; const h16* src_ = QIDX + (size_t)(tok0 + q) * 512 + part * 32; LAS unsigned char* dst = lds + L_QS + q * QS_STRIDE + part * 64;
#pragma unroll
              for (int e = 0; e < 4; ++e) *(LAS h16x8*)(dst + 16 * e) = *(const h16x8*)(src_ + 8 * e); }
            if (tid < 256) {
                const int q = tid >> 3, h = tid & 7; const h16* qp = QIDX + (size_t)(tok0 + q) * 512 + h * 64; float s2 = 0.f;
#pragma unroll
                for (int e = 0; e < 8; ++e) { const h16x8 v = *(const h16x8*)(qp + 8 * e);
#pragma unroll
                    for (int k = 0; k < 8; ++k) s2 += (float)v[k] * (float)v[k]; }
                const float wv = WIDX[(size_t)(tok0 + q) * 8 + h];
                ((LAS float*)(lds + L_QN))[tid] = sqrtf(s2) * fabsf(wv); ((LAS float*)(lds + L_WQ))[tid] = wv; }
            __syncthreads();
            if (tid < 32) { const float kmax = sqrtf(__uint_as_float(__hip_atomic_load(kmaxp + b, __ATOMIC_RELAXED, __HIP_MEMORY_SCOPE_AGENT))); float bp = 0.f, bn = 0.f;
#pragma unroll
                for (int h = 0; h < 8; ++h) { const float t = ((const LAS float*)(lds + L_QN))[tid * 8 + h] * kmax; if (((const LAS float*)(lds + L_WQ))[tid * 8 + h] > 0.f) bp += t; else bn += t; }
                ((LAS float*)(lds + L_META))[tid] = bp > 0.f ? 1.0f / (bp * 1.0005f) : 0.f; ((LAS float*)(lds + L_META + 128))[tid] = bn > 0.f ? 1.0f / (bn * 1.0005f) : 0.f; }
#pragma unroll
            for (int e = 0; e < 8; ++e) ((LAS u32x4*)(lds + L_HIST))[tid + e * NTHREADS] = (u32x4){0u, 0u, 0u, 0u};
            if (tid < 64) ((LAS unsigned*)(lds + L_META + 512))[tid] = 0u;
            if (tid == 0) misc[1] = 0;
            __syncthreads();
            const h16* kb = KIDX + (size_t)b * SEQ * IDXD; const int npair = N >> 5;
            float* scache = (float*)(ws + scache_off((int)blockIdx.x));
            index_pass<1>(lds, kb, npair, wid, lane, scache);
            __syncthreads();
#if REP_PHASE == 32
            for (int e = 0; e < 8; ++e) ((LAS u32x4*)(lds + L_HIST))[tid + e * NTHREADS] = (u32x4){0u, 0u, 0u, 0u};
            __syncthreads();
            index_pass<1>(lds, kb, npair, wid, lane, scache);
            __syncthreads();
#endif
            for (int i = 0; i < 4; ++i) { const int q = wid * 4 + i; int tbin; unsigned nab, nin;
                find_thr(lds, q, (unsigned)TOPK, lane, tbin, nab, nin);
                if (lane == 0) { const bool fl = nin > (unsigned)CC;
                    ((LAS unsigned*)(lds + L_META + 256))[q] = fl ? (unsigned)tbin : ((unsigned)tbin << 10);
                    ((LAS unsigned*)(lds + L_META + 768))[q] = fl ? 1u : (((unsigned)tbin + 1u) << 10);
                    ((LAS int*)(lds + L_META + 384))[q] = (int)nab;
                    if (fl) misc[1] = 1; } }
            __syncthreads();
            if (misc[1] != 0) {
#pragma unroll
                for (int e = 0; e < 8; ++e) ((LAS u32x4*)(lds + L_HIST))[tid + e * NTHREADS] = (u32x4){0u, 0u, 0u, 0u};
                unsigned myflag = 0, mytb = 0;
                if (tid < 32) { myflag = ((const LAS unsigned*)(lds + L_META + 768))[tid] == 1u; mytb = ((const LAS unsigned*)(lds + L_META + 256))[tid]; }
                __syncthreads();
                if (tid < 32 && !myflag) ((LAS unsigned*)(lds + L_META + 256))[tid] = 0xffffffffu;
                __syncthreads();
                scan_scores<2>(lds, scache, N, wid, lane);
                __syncthreads();
                if (tid < 32 && !myflag) ((LAS unsigned*)(lds + L_META + 256))[tid] = mytb;
                for (int i = 0; i < 4; ++i) { const int q = wid * 4 + i;
                    const bool fl = ((const LAS unsigned*)(lds + L_META + 768))[q] == 1u;
                    if (fl) { const unsigned tb1 = ((const LAS unsigned*)(lds + L_META + 256))[q]; const int nab1 = ((const LAS int*)(lds + L_META + 384))[q];
                        int tsub; unsigned nab2, nin2; find_thr(lds, q, (unsigned)(TOPK - nab1), lane, tsub, nab2, nin2);
                        if (lane == 0) { const unsigned tl = (tb1 << 10) | (unsigned)tsub;
                            ((LAS unsigned*)(lds + L_META + 256))[q] = tl; ((LAS unsigned*)(lds + L_META + 768))[q] = tl + 1u; ((LAS int*)(lds + L_META + 384))[q] = nab1 + (int)nab2; } } }
                __syncthreads();
            }
            scan_scores<3>(lds, scache, N, wid, lane);
            __syncthreads();
#if REP_PHASE == 33
            if (tid < 64) ((LAS unsigned*)(lds + L_META + 512))[tid] = 0u;
            __syncthreads();
            scan_scores<3>(lds, scache, N, wid, lane);
            __syncthreads();
#endif
            for (int i = 0; i < 4; ++i) { const int q = wid * 4 + i;
                const unsigned mc = ((const LAS unsigned*)(lds + L_META + 640))[q]; const int m = mc < (unsigned)CC ? (int)mc : CC;
                const int nab = ((const LAS int*)(lds + L_META + 384))[q], need = TOPK - nab;
                const LAS u32x2* cd = (const LAS u32x2*)(lds + L_CAND) + q * CC;
                for (int c = lane; c < m; c += 64) { const u32x2 me = cd[c]; const float sc = __uint_as_float(me[0]); int rank = 0;
                    for (int k = 0; k < m; ++k) { const u32x2 ot = cd[k]; const float so = __uint_as_float(ot[0]); rank += (so > sc || (so == sc && ot[1] < me[1])) ? 1 : 0; }
                    if (rank < need) ((LAS unsigned short*)(lds + L_SEL))[q * 256 + nab + rank] = (unsigned short)me[1]; } }
        }
        }
        __syncthreads();
        const int cnt = N < TOPK ? N : TOPK;
#if REP_PHASE == 37 || REP_PHASE == 38
        for (int i = 0; i < 4; ++i) { const int qi = wid * 4 + i; attn_query<REP_PHASE - 36>(lds, QA + (size_t)(tok0 + qi) * (NH * KVD), KV + (size_t)b * SEQ * KVD, qi, cnt, wid, lane); }
#endif
        for (int rep_ = 0; rep_ < REPATT; ++rep_)
        for (int i = 0; i < 4; ++i) { const int qi = wid * 4 + i; attn_query<0>(lds, QA + (size_t)(tok0 + qi) * (NH * KVD), KV + (size_t)b * SEQ * KVD, qi, cnt, wid, lane); }
        __syncthreads();
        {
            int lane2 = lane; asm volatile("" : "+v"(lane2));
            const int r = lane2 & 31, hh = lane2 >> 5;
            f32x16 acc0, acc1;
#pragma unroll
            for (int i = 0; i < 16; ++i) { acc0[i] = 0.f; acc1[i] = 0.f; }
            const h16* wu = WuvT + (size_t)(wid * 64 + r) * 128 + 8 * hh;
            const LAS unsigned char* ap = lds + L_OLAT + r * OL_STRIDE + wid * 256 + 16 * hh;
#pragma unroll
            for (int ks = 0; ks < 8; ++ks) { const h16x8 af = *(const LAS h16x8*)(ap + 32 * ks); const h16x8 b0 = *(const h16x8*)(wu + 16 * ks), b1 = *(const h16x8*)(wu + 32 * 128 + 16 * ks);
                acc0 = __builtin_amdgcn_mfma_f32_32x32x16_f16(af, b0, acc0, 0, 0, 0); acc1 = __builtin_amdgcn_mfma_f32_32x32x16_f16(af, b1, acc1, 0, 0, 0); }
            LAS unsigned char* ob = lds + L_VBUF + (wid * 64 + r) * 2;
#pragma unroll
            for (int i = 0; i < 16; ++i) { const int q = (i & 3) + 8 * (i >> 2) + 4 * hh;
                *(LAS h16*)(ob + q * 1040) = (h16)acc0[i]; *(LAS h16*)(ob + q * 1040 + 64) = (h16)acc1[i]; }
        }
        __syncthreads();
        {
            int t2 = tid; asm volatile("" : "+v"(t2));
            const int q = t2 >> 4, c0 = (t2 & 15) * 32; const size_t tok = (size_t)(tok0 + q);
#pragma unroll
            for (int e = 0; e < 4; ++e) { const h16x8 ov = *(const LAS h16x8*)(lds + L_VBUF + q * 1040 + (c0 + 8 * e) * 2); const h16x8 zv = *(const h16x8*)(ZB + tok * GW + c0 + 8 * e); h16x8 o;
#pragma unroll
                for (int k = 0; k < 8; ++k) o[k] = (h16)((float)ov[k] * (float)zv[k]);
                *(h16x8*)(A2 + tok * DM + 512 + c0 + 8 * e) = o; }
        }
        __syncthreads();
    }
}
}


__device__ __forceinline__ void final_phase(const Args& a, const int g_wid) {
    int tid_ = TID(); asm volatile("" : "+v"(tid_));
    const h16* Y = (const h16*)(a.ws + WS_Y); const float* ssy = (const float*)(a.ws + WS_SSY);
    const size_t n4 = (size_t)T * DM / 4;
    for (size_t i = (size_t)blockIdx.x * blockDim.x + tid_; i < n4; i += (size_t)gridDim.x * blockDim.x) {
        const int row = (int)(i >> 8), c4 = (int)(i & 255);
        const float rstd = rsqrtf(ssy[row] * (1.f / DM) + EPS);
        const f32x4 xv = *((const f32x4*)a.x + i); const f32x4 g = *((const f32x4*)a.post_g + c4); const h16x4 yv = *((const h16x4*)Y + i);
        f32x4 o; o.x = xv.x + (float)yv.x * rstd * g.x; o.y = xv.y + (float)yv.y * rstd * g.y; o.z = xv.z + (float)yv.z * rstd * g.z; o.w = xv.w + (float)yv.w * rstd * g.w;
        *((f32x4*)a.out + i) = o;
    }
}


namespace gm {
constexpr int L_VN = 0;
constexpr int L_ST = 32768;
__device__ __forceinline__ int swz(int row) { return 2 * ((row & 3) | (((row >> 3) & 1) << 2)); }
__device__ __forceinline__ void phase(LAS unsigned char* lds, const Args& a, const int g_wid) {
    unsigned char* ws = a.ws;
    const h16* U = (const h16*)(ws + WS_U); const h16* V = (const h16*)(ws + WS_V); const h16* ZA = (const h16*)(ws + WS_ZA);
    const h16* WsH = (const h16*)(ws + WS_WSH); h16* A2 = (h16*)(ws + WS_A2);
    int tid = TID(); asm volatile("" : "+v"(tid));
    const int wid = __builtin_amdgcn_readfirstlane(tid >> 6), lane = tid & 63;
    for (int nb = blockIdx.x; nb < T / 128; nb += gridDim.x) {
        const int tok0 = nb * 128;
        {
            const int row = tid >> 2, part = tid & 3; const h16* vr = V + (size_t)(tok0 + row) * GW + part * 128; float s = 0.f, q = 0.f;
#pragma unroll 4
            for (int e = 0; e < 16; ++e) { const h16x8 v = *(const h16x8*)(vr + 8 * e);
#pragma unroll
                for (int k = 0; k < 8; ++k) { const float f = (float)v[k]; s += f; q += f * f; } }
            s += __shfl_xor(s, 1); s += __shfl_xor(s, 2); q += __shfl_xor(q, 1); q += __shfl_xor(q, 2);
            const float m = s * (1.f / GW), var = fmaxf(q * (1.f / GW) - m * m, 0.f);
            if (part == 0) { ((LAS float*)(lds + L_ST))[row] = m; ((LAS float*)(lds + L_ST))[128 + row] = rsqrtf(var + EPS); } }
        __syncthreads();
        for (int g = 0; g < 4; ++g) {
            {
                const int row = tid >> 2, part = tid & 3; const float m = ((const LAS float*)(lds + L_ST))[row], rs = ((const LAS float*)(lds + L_ST))[128 + row];
                const h16* vr = V + (size_t)(tok0 + row) * GW + g * 128 + part * 32; const float* lg = a.ln_g + g * 128 + part * 32; const float* lb = a.ln_b + g * 128 + part * 32;
                const int sw = swz(row);
#pragma unroll
                for (int e = 0; e < 4; ++e) { const h16x8 v = *(const h16x8*)(vr + 8 * e); h16x8 o;
#pragma unroll
                    for (int k = 0; k < 8; ++k) o[k] = (h16)(((float)v[k] - m) * rs * lg[8 * e + k] + lb[8 * e + k]);
                    *(LAS h16x8*)(lds + L_VN + row * 256 + (((part * 4 + e) ^ sw) << 4)) = o; } }
            __syncthreads();
            {
                const int c15 = lane & 15, gq = lane >> 4, qq = c15 >> 2, pp = c15 & 3;
                const h16* wp = WsH + (size_t)(g * 128 + wid * 16 + c15) * 128 + 8 * gq;
                h16x8 wf[4];
#pragma unroll
                for (int ks = 0; ks < 4; ++ks) wf[ks] = *(const h16x8*)(wp + 32 * ks);
                f32x4 acc[8];
#pragma unroll
                for (int ct = 0; ct < 8; ++ct) acc[ct] = (f32x4){0.f, 0.f, 0.f, 0.f};
#pragma unroll
                for (int ks = 0; ks < 4; ++ks) {
                    const int r0 = 32 * ks + 8 * gq + qq, r1 = r0 + 4;
                    const unsigned b0 = (unsigned)(uintptr_t)(lds + L_VN + r0 * 256 + 16 * (pp >> 1) + 8 * (pp & 1)), b1 = (unsigned)(uintptr_t)(lds + L_VN + r1 * 256 + 16 * (pp >> 1) + 8 * (pp & 1));
                    const int s0 = swz(r0) >> 1, s1 = swz(r1) >> 1;
                    p3::s16x4 lo[8], hi[8];
#pragma unroll
                    for (int ct = 0; ct < 8; ++ct) { const unsigned a0 = b0 + (unsigned)((ct ^ s0) << 5), a1 = b1 + (unsigned)((ct ^ s1) << 5);
                        asm volatile("ds_read_b64_tr_b16 %0, %1" : "=&v"(lo[ct]) : "v"(a0) : "memory");
                        asm volatile("ds_read_b64_tr_b16 %0, %1" : "=&v"(hi[ct]) : "v"(a1) : "memory"); }
                    asm volatile("s_waitcnt lgkmcnt(0)" ::: "memory"); __builtin_amdgcn_sched_barrier(0);
#pragma unroll
                    for (int ct = 0; ct < 8; ++ct) { typedef short s16x8 __attribute__((ext_vector_type(8)));
                        const s16x8 va = (s16x8){lo[ct][0], lo[ct][1], lo[ct][2], lo[ct][3], hi[ct][0], hi[ct][1], hi[ct][2], hi[ct][3]};
                        acc[ct] = __builtin_amdgcn_mfma_f32_16x16x32_f16(__builtin_bit_cast(h16x8, va), wf[ks], acc[ct], 0, 0, 0); }
                }
                const int tl = wid * 16 + c15; const float bs = a.b_s[g * 128 + tl]; const size_t tok = (size_t)(tok0 + tl);
#pragma unroll
                for (int ct = 0; ct < 8; ++ct) { const int ch = g * 128 + 16 * ct + 4 * gq;
                    const h16x4 uu = *(const h16x4*)(U + tok * GW + ch), zz = *(const h16x4*)(ZA + tok * GW + ch); h16x4 o;
#pragma unroll
                    for (int e = 0; e < 4; ++e) o[e] = (h16)((float)uu[e] * (acc[ct][e] + bs) * (float)zz[e]);
                    *(h16x4*)(A2 + tok * DM + ch) = o; }
            }
            __syncthreads();
        }
    }
}
}

#define XB_TMO      128
#define XB_XCNT(j)  (256  + 64 * (j))
#define XB_XSUB(j)  (1280 + 64 * (j))
#define XB_XGEN(j)  (2304 + 64 * (j))
#define XB_TOP      3328
#define XB_TOPGEN   3392
#define XCD_BAR_WORDS 3456
#define XB_SPIN_CAP (1u << 18)
__device__ __forceinline__ unsigned xb_ld(unsigned* p)              { return __hip_atomic_load(p, __ATOMIC_RELAXED, __HIP_MEMORY_SCOPE_AGENT); }
__device__ __forceinline__ unsigned xb_add(unsigned* p, unsigned v) { return __hip_atomic_fetch_add(p, v, __ATOMIC_RELAXED, __HIP_MEMORY_SCOPE_AGENT); }
__device__ __forceinline__ unsigned xb_xcc_id() { return (unsigned)__builtin_amdgcn_s_getreg((3 << 11) | 20) & 0xFu; }
#define XB_SPIN(cond, bar) do { unsigned _sp = 0; while (cond) { __builtin_amdgcn_s_sleep(1); \
    if ((++_sp & 255u) == 0u) { if (xb_ld(&(bar)[XB_TMO])) break; if (_sp > XB_SPIN_CAP) { atomicAdd(&(bar)[XB_TMO], 1u); break; } } } } while (0)
struct XcdBarrier { unsigned* bar; unsigned x; volatile LAS unsigned* st; };
__device__ __forceinline__ XcdBarrier xcd_barrier_post(unsigned* bar, volatile LAS unsigned* st, const int g_wid) {
    XcdBarrier b; b.bar = bar; b.x = xb_xcc_id(); b.st = st;
    if (TID() == 0) (void)xb_add(&bar[XB_XCNT(b.x)], 1u);
    return b;
}
__device__ __forceinline__ void xcd_barrier_complete(unsigned* bar, unsigned x, unsigned& nloc, unsigned& nx) {
    const unsigned G = gridDim.x * gridDim.y * gridDim.z;
    unsigned sum, cnt, mine, sp = 0u;
    for (;;) {
        sum = 0u; cnt = 0u; mine = 0u;
#pragma unroll
        for (unsigned j = 0; j < 16; ++j) { const unsigned c = xb_ld(&bar[XB_XCNT(j)]); sum += c; cnt += (c > 0u) ? 1u : 0u; mine = (j == x) ? c : mine; }
        if (sum == G) break;
        __builtin_amdgcn_s_sleep(1);
        if ((++sp & 255u) == 0u) { if (xb_ld(&bar[XB_TMO])) break; if (sp > XB_SPIN_CAP) { atomicAdd(&bar[XB_TMO], 1u); break; } }
    }
    nloc = mine > 0u ? mine : 1u; nx = cnt > 0u ? cnt : 1u;
}
__device__ __forceinline__ void xcd_barrier(const XcdBarrier& b, const int g_wid) {
    asm volatile("s_waitcnt vmcnt(0)" ::: "memory");
    __syncthreads();
    if (TID() == 0) {
        unsigned* bar = b.bar;
        __builtin_amdgcn_s_waitcnt(0);
        unsigned nloc = b.st[0], nx = b.st[1];
        if (nloc == 0u) { xcd_barrier_complete(bar, b.x, nloc, nx); b.st[0] = nloc; b.st[1] = nx; }
        const unsigned old = xb_add(&bar[XB_XSUB(b.x)], 1u);
        const unsigned gen = old / nloc;
        if (old + 1u == (gen + 1u) * nloc) {
            __builtin_amdgcn_fence(__ATOMIC_RELEASE, "agent");
            asm volatile("s_waitcnt vmcnt(0)" ::: "memory");
            const unsigned og = xb_add(&bar[XB_TOP], 1u);
            const unsigned tg = og / nx;
            if (og + 1u == (tg + 1u) * nx) xb_add(&bar[XB_TOPGEN], 1u);
            else XB_SPIN(xb_ld(&bar[XB_TOPGEN]) == tg, bar);
            __builtin_amdgcn_fence(__ATOMIC_ACQUIRE, "agent");
            xb_add(&bar[XB_XGEN(b.x)], 1u);
            asm volatile("s_waitcnt vmcnt(0)" ::: "memory");
        } else {
            XB_SPIN(xb_ld(&bar[XB_XGEN(b.x)]) == gen, bar);
            __builtin_amdgcn_fence(__ATOMIC_ACQUIRE, "agent");
            asm volatile("s_waitcnt vmcnt(0)" ::: "memory");
        }
    }
    __syncthreads();
}

#ifndef MK_PER_PHASE
#define MK_PER_PHASE 0
#endif
constexpr int LDS_TOTAL = 153600;
constexpr int L_BARST = LDS_TOTAL - 64;
constexpr size_t WS_BAR = 16384;
static_assert(p3::L_END <= L_BARST && pg8::STAGE_BYTES <= L_BARST && WS_BAR + XCD_BAR_WORDS * 4 <= WS_SSQ, "maps");

struct MArgs { Args a; int ph_lo, ph_hi; };
__global__ __launch_bounds__(NTHREADS, 2) void mega(MArgs m) {
    extern __shared__ __attribute__((aligned(16))) unsigned char lds_raw[];
    LAS unsigned char* lds = (LAS unsigned char*)lds_raw;
    const Args& a = m.a; unsigned char* ws = a.ws;
    volatile LAS unsigned* st = (volatile LAS unsigned*)(lds + L_BARST);
    const int g_wid = 0;
    if (threadIdx.x < 16) st[threadIdx.x] = 0u;
    __syncthreads();
    XcdBarrier bar; bar.bar = (unsigned*)(ws + WS_BAR); bar.x = 0; bar.st = st;
    if (!MK_PER_PHASE) bar = xcd_barrier_post((unsigned*)(ws + WS_BAR), st, g_wid);
#define IN(k) (m.ph_lo <= (k) && (k) < m.ph_hi)
#define SEAM(k) do { if (IN(k) && IN((k) + 1)) xcd_barrier(bar, g_wid); } while (0)
    constexpr size_t WS_DUMMY = 443 * MiB;
#define REPS(k) ((REP_PHASE == (k)) ? 2 : 1)
    for (int rp = 0; rp < REPS(0); ++rp) { if (rp) xcd_barrier(bar, g_wid);
    if (IN(0)) { prep_weights(a, g_wid); prep_x(a, g_wid); } }
    SEAM(0);
    for (int rp = 0; rp < REPS(1); ++rp) { if (rp) xcd_barrier(bar, g_wid);
    if (IN(1)) {
        pg8::Gemm g{(const h16*)(ws + WS_X16), (const h16*)(ws + WS_WINT), T, NP, DM};
        pg8::StaticOrder S; S.init(T, NP, gridDim.x, blockIdx.x);
        pg8::EpiProj E{(h16*)(ws + WS_U), (h16*)(ws + WS_V), (h16*)(ws + WS_ZA), (h16*)(ws + WS_ZB), (h16*)(ws + WS_CQ), (h16*)(ws + WS_KV), (h16*)(ws + WS_KIDX),
                       (float*)(ws + WS_CKVR), (float*)(ws + WS_WIDX), (float*)(ws + (rp ? WS_DUMMY : WS_SSQ)), (float*)(ws + (rp ? WS_DUMMY + T * 4 : WS_SSKV)), (const float*)(ws + WS_ROPE)};
        pg8::gemm_phase<pg8::EpiProj, true>(lds, g, S, E, g_wid);
    } }
    SEAM(1);
    if (IN(2)) {
        for (int rp = 0; rp < REPS(20); ++rp)
        { pg8::Gemm g{(const h16*)(ws + WS_CQ), (const h16*)(ws + WS_W2T), T, N2, QR};
          pg8::StaticOrder S; S.init(T, N2, gridDim.x, blockIdx.x);
          pg8::EpiQ E{(h16*)(ws + WS_QA), (h16*)(ws + WS_QIDX), (const float*)(ws + WS_SSQ), (const float*)(ws + WS_ROPE)};
          pg8::gemm_phase<pg8::EpiQ, true>(lds, g, S, E, g_wid); }
        for (int rp = 0; rp < REPS(21); ++rp) gm::phase(lds, a, g_wid);
        for (int rp = 0; rp < REPS(22); ++rp) ckvnorm_phase(a, g_wid);
    }
    SEAM(2);
    for (int rp = 0; rp < REPS(3); ++rp) { if (rp) xcd_barrier(bar, g_wid);
    if (IN(3)) p3::phase<REPS(30), REPS(31)>(lds, ws, rp ? 2048 : 0, g_wid); }
    SEAM(3);
    for (int rp = 0; rp < REPS(4); ++rp) { if (rp) xcd_barrier(bar, g_wid);
    if (IN(4)) {
        pg8::Gemm g{(const h16*)(ws + WS_A2), (const h16*)(ws + WS_WOUTT), T, DM, DM};
        pg8::StaticOrder S; S.init(T, DM, gridDim.x, blockIdx.x);
        pg8::EpiOut E{(h16*)(ws + WS_Y), (float*)(ws + (rp ? WS_DUMMY : WS_SSY))};
        pg8::gemm_phase<pg8::EpiOut, true>(lds, g, S, E, g_wid);
    } }
    SEAM(4);
    for (int rp = 0; rp < REPS(5); ++rp) { if (rp) xcd_barrier(bar, g_wid);
    if (IN(5)) final_phase(a, g_wid); }
#undef IN
#undef SEAM
}

extern "C" void kernel_launch(void* const* d_in, const int* in_sizes, int n_in, void* d_out, int out_size, void* d_ws, size_t ws_size, hipStream_t stream) {
    static int grid = 0;
    if (grid == 0) {
        if (n_in != 15 || ws_size < WS_END) { fprintf(stderr, "kernel_launch: unexpected n_in %d / ws %zu\n", n_in, ws_size); grid = -1; return; }
        int dev = 0, cus = 0;
        if (hipGetDevice(&dev) != hipSuccess || hipDeviceGetAttribute(&cus, hipDeviceAttributeMultiprocessorCount, dev) != hipSuccess) { grid = -1; return; }
        if (hipFuncSetAttribute((const void*)mega, hipFuncAttributeMaxDynamicSharedMemorySize, LDS_TOTAL) != hipSuccess) { fprintf(stderr, "kernel_launch: hipFuncSetAttribute failed\n"); grid = -1; return; }
        grid = cus < 256 ? cus : 256;
    }
    if (grid < 0) return;
    (void)hipMemsetAsync((char*)d_ws + WS_CTL, 0, 1 * MiB, stream);
    MArgs m{};
    Args& a = m.a;
    a.x = (const float*)d_in[0]; a.w_in = (const float*)d_in[1]; a.pre_g = (const float*)d_in[2]; a.post_g = (const float*)d_in[3];
    a.ln_g = (const float*)d_in[4]; a.ln_b = (const float*)d_in[5]; a.w_s = (const float*)d_in[6]; a.b_s = (const float*)d_in[7];
    a.qn_g = (const float*)d_in[8]; a.kvn_g = (const float*)d_in[9]; a.w_uq = (const float*)d_in[10]; a.w_uk = (const float*)d_in[11];
    a.w_uv = (const float*)d_in[12]; a.w_qidx = (const float*)d_in[13]; a.w_out = (const float*)d_in[14];
    a.out = (float*)d_out; a.ws = (unsigned char*)d_ws;
#if MK_PER_PHASE
    for (int p = 0; p < 6; ++p) { m.ph_lo = p; m.ph_hi = p + 1; hipLaunchKernelGGL(mega, dim3(grid), dim3(NTHREADS), LDS_TOTAL, stream, m); }
#else
    m.ph_lo = 0; m.ph_hi = 6;
    hipLaunchKernelGGL(mega, dim3(grid), dim3(NTHREADS), LDS_TOTAL, stream, m);
#endif
}
```

```cpp
#include <hip/hip_runtime.h>
#ifndef REP_PHASE
#define REP_PHASE -1
#endif
#include <cstdio>
#include <cstdint>

typedef _Float16 h16;
typedef _Float16 h16x8 __attribute__((ext_vector_type(8)));
typedef _Float16 h16x4 __attribute__((ext_vector_type(4)));
typedef float f32x4 __attribute__((ext_vector_type(4)));

constexpr int BATCH = 4, SEQ = 8192, T = BATCH * SEQ, DM = 1024;
constexpr int NIN = 2536, NP = 2560;
constexpr int GW = 512;
constexpr int QR = 256, CKV = 128, ROPE = 32, IDXD = 64, NH = 8;
constexpr int KVD = CKV + ROPE;
constexpr int N2 = 1792;
constexpr int TOPK = 256;
constexpr float EPS = 1e-6f;
constexpr int C_U = 0, C_V = 512, C_ZA = 1024, C_ZB = 1536, C_CQ = 2048, C_CKV = 2304, C_KR = 2432, C_KI = 2464, C_WI = 2528;
__host__ __device__ inline int old_col(int n) {
    if (n < 1536) return n;
    if (n < 2048) return 2024 + (n - 1536);
    if (n < 2304) return 1536 + (n - 2048);
    if (n < 2432) return 1792 + (n - 2304);
    if (n < 2464) { const int rho = n - 2432; return 1920 + 16 * ((rho >> 2) & 1) + 4 * (rho >> 3) + (rho & 3); }
    if (n < 2528) return 1952 + (n - 2464);
    if (n < 2536) return 2016 + (n - 2528);
    return -1;
}

constexpr size_t MiB = 1u << 20;
constexpr size_t WS_CTL = 0;
constexpr size_t WS_SSQ = 64 * 1024;
constexpr size_t WS_SSKV = WS_SSQ + T * 4;
constexpr size_t WS_SSY = WS_SSKV + T * 4;
constexpr size_t WS_KMAX = WS_SSY + T * 4;
constexpr size_t WS_QUEUE = 4096;
constexpr size_t WS_WINT = 1 * MiB;
constexpr size_t WS_W2T = 6 * MiB;
constexpr size_t WS_WOUTT = 7 * MiB;
constexpr size_t WS_WUVT = 9 * MiB;
constexpr size_t WS_WSH = 9 * MiB + 256 * 1024;
constexpr size_t WS_ROPE = 10 * MiB;
constexpr size_t WS_WIDX = 11 * MiB;
constexpr size_t WS_CNT = 12 * MiB;
constexpr size_t WS_KIDX = 13 * MiB;
constexpr size_t WS_KV = 17 * MiB;
constexpr size_t WS_CQ = 27 * MiB;
constexpr size_t WS_CKVR = 43 * MiB;
constexpr size_t WS_SEL = 59 * MiB;
constexpr size_t WS_X16 = 75 * MiB;
constexpr size_t WS_Y = WS_X16;
constexpr size_t WS_U = 139 * MiB;
constexpr size_t WS_V = 171 * MiB;
constexpr size_t WS_ZA = 203 * MiB;
constexpr size_t WS_ZB = 235 * MiB;
constexpr size_t WS_QIDX = 267 * MiB;
constexpr size_t WS_QA = 299 * MiB;
constexpr size_t WS_A2 = 379 * MiB;
constexpr size_t WS_END = 491 * MiB;
__host__ __device__ inline size_t scache_off(int wg) { return wg < 48 ? (27 + (size_t)wg) * MiB : wg < 208 ? (75 + (size_t)(wg - 48)) * MiB : (443 + (size_t)(wg - 208)) * MiB; }

struct Args {
    const float* x; const float* w_in; const float* pre_g; const float* post_g; const float* ln_g; const float* ln_b;
    const float* w_s; const float* b_s; const float* qn_g; const float* kvn_g; const float* w_uq; const float* w_uk;
    const float* w_uv; const float* w_qidx; const float* w_out;
    float* out; unsigned char* ws;
};


__device__ __forceinline__ int lane_id() { int l; asm volatile("v_mbcnt_lo_u32_b32 %0, -1, 0\n\tv_mbcnt_hi_u32_b32 %0, -1, %0" : "=v"(l)); return l; }
#define TID() ((int)threadIdx.x)
__device__ __forceinline__ float gelu_erf(float v) { return 0.5f * v * (1.0f + erff(v * 0.70710678118654752f)); }
__device__ __forceinline__ float silu(float v) { return v / (1.0f + __expf(-v)); }

__device__ __forceinline__ void prep_weights(const Args& a, const int g_wid, __attribute__((address_space(3))) unsigned char* lds) {
    int tid_ = TID(); asm volatile("" : "+v"(tid_));
    const int gtid = blockIdx.x * blockDim.x + tid_, gsz = gridDim.x * blockDim.x;
    unsigned char* ws = a.ws;
    {
        h16* WinT = (h16*)(ws + WS_WINT); h16* WoutT = (h16*)(ws + WS_WOUTT);
        const int wv = tid_ >> 6, lane = tid_ & 63, gw = blockIdx.x * 8 + wv, ngw = gridDim.x * 8;
        __attribute__((address_space(3))) float* scr = (__attribute__((address_space(3))) float*)(lds + wv * 8448);
        constexpr int I_IN = (DM / 64) * (NP / 32), I_OUT = (DM / 64) * (DM / 32);
        for (int it = gw; it < I_IN + I_OUT; it += ngw) {
            const bool isin = it < I_IN; const int r = isin ? it : it - I_IN, nblk = isin ? NP / 32 : DM / 32, kb = r / nblk, nb = r % nblk, k0 = 64 * kb, n0 = 32 * nb;
            const int nn = lane & 31, oc = isin ? old_col(n0 + nn) : n0 + nn; const float* W = isin ? a.w_in : a.w_out; const int ldw = isin ? NIN : DM;
#pragma unroll 8
            for (int i = 0; i < 32; ++i) { const int kk = 2 * i + (lane >> 5); scr[kk * 33 + nn] = oc >= 0 ? W[(size_t)(k0 + kk) * ldw + oc] : 0.f; }
            asm volatile("s_waitcnt lgkmcnt(0)" ::: "memory");
            const int c = lane & 7; h16* WT = isin ? WinT : WoutT;
#pragma unroll
            for (int j = 0; j < 4; ++j) { const int n = (lane >> 3) + 8 * j; const __attribute__((address_space(3))) float* s = scr + (8 * c) * 33 + n; h16x8 o;
#pragma unroll
                for (int e = 0; e < 8; ++e) o[e] = (h16)s[e * 33];
                *(h16x8*)(WT + (size_t)(n0 + n) * DM + k0 + 8 * c) = o; }
            asm volatile("s_waitcnt lgkmcnt(0)" ::: "memory");
        }
    }
    h16* W2T = (h16*)(ws + WS_W2T);
    {
        const int wv = tid_ >> 6, lane = tid_ & 63, gw = blockIdx.x * 8 + wv, ngw = gridDim.x * 8;
        for (int it = gw; it < 8 * 32 * 2; it += ngw) {
            const int h = it >> 6, kb = (it >> 1) & 31, c = (it & 1) * 64 + lane;
            const float* uk = a.w_uk + (size_t)c * 512 + h * 64; f32x4 ukr[16];
#pragma unroll
            for (int e = 0; e < 16; ++e) ukr[e] = *(const f32x4*)(uk + 4 * e);
            h16x8 o;
#pragma unroll
            for (int kk = 0; kk < 8; ++kk) { const int k = kb * 8 + kk; const float* uq = a.w_uq + (size_t)k * 768 + h * 96; float s = 0.f;
#pragma unroll
                for (int e = 0; e < 16; ++e) { const f32x4 q4 = *(const f32x4*)(uq + 4 * e); s += (q4[0] * ukr[e][0] + q4[1] * ukr[e][1]) + (q4[2] * ukr[e][2] + q4[3] * ukr[e][3]); }
                o[kk] = (h16)(s * a.qn_g[k]); }
            *(h16x8*)(W2T + (size_t)(h * 128 + c) * QR + kb * 8) = o;
        }
    }
    for (int i = gtid; i < (N2 - 1024) * QR; i += gsz) {
        const int k = i / (N2 - 1024), n = 1024 + i % (N2 - 1024); float v;
        if (n < 1536) { v = a.w_qidx[(size_t)k * 512 + (n - 1024)]; }
        else { const int j = n - 1536, h = j >> 5, rho = j & 31, r = 16 * ((rho >> 2) & 1) + 4 * (rho >> 3) + (rho & 3); v = a.w_uq[(size_t)k * 768 + h * 96 + 64 + r]; }
        W2T[(size_t)n * QR + k] = (h16)(v * a.qn_g[k]);
    }
    h16* WuvT = (h16*)(ws + WS_WUVT);
    for (int i = gtid; i < 128 * 512; i += gsz) { const int c = i / 512, hd = i % 512, h = hd >> 6, d = hd & 63; WuvT[(size_t)(h * 64 + d) * 128 + c] = (h16)a.w_uv[i]; }
    h16* WsH = (h16*)(ws + WS_WSH);
    for (int i = gtid; i < 4 * 128 * 128; i += gsz) { const int t = (i >> 7) & 127, s = i & 127; WsH[i] = (h16)(((s >> 6) <= (t >> 6)) ? a.w_s[i] : 0.f); }
    float2* rope = (float2*)(ws + WS_ROPE);
    for (int i = gtid; i < SEQ * 16; i += gsz) {
        const int pos = i >> 4, j = i & 15;
        const double invf = exp2(-(double)j * (13.287712379549449 / 16.0));
        const double ang = (double)pos * invf;
        const double n = rint(ang * 0.15915494309189535);
        const float r = (float)(ang - n * 6.283185307179586);
        rope[i] = make_float2(cosf(r), sinf(r));
    }
}

__device__ __forceinline__ void prep_x(const Args& a, const int g_wid) {
    int tid_ = TID(); asm volatile("" : "+v"(tid_));
    const int lane = tid_ & 63, gw = (blockIdx.x * blockDim.x + tid_) >> 6, ngw = (gridDim.x * blockDim.x) >> 6;
    h16* X16 = (h16*)(a.ws + WS_X16);
    for (int row = gw; row < T; row += ngw) {
        const f32x4* xr = (const f32x4*)(a.x + (size_t)row * DM) + lane;
        f32x4 v[4]; float s = 0.f;
#pragma unroll
        for (int j = 0; j < 4; ++j) { v[j] = xr[64 * j]; s += (v[j].x * v[j].x + v[j].y * v[j].y) + (v[j].z * v[j].z + v[j].w * v[j].w); }
#pragma unroll
        for (int o = 1; o < 64; o <<= 1) s += __shfl_xor(s, o);
        const float rstd = rsqrtf(s * (1.f / DM) + EPS);
#pragma unroll
        for (int j = 0; j < 4; ++j) {
            const f32x4 g = *((const f32x4*)a.pre_g + lane + 64 * j);
            h16x4 o; o.x = (h16)(v[j].x * rstd * g.x); o.y = (h16)(v[j].y * rstd * g.y); o.z = (h16)(v[j].z * rstd * g.z); o.w = (h16)(v[j].w * rstd * g.w);
            *((h16x4*)(X16 + (size_t)row * DM) + lane + 64 * j) = o;
        }
    }
}

namespace pg8 {
#define PG8_LAS __attribute__((address_space(3)))
typedef unsigned u32x4 __attribute__((ext_vector_type(4)));
typedef float f32x2 __attribute__((ext_vector_type(2)));
constexpr int BM = 256, BK = 64, HALF = 128, HTB = HALF * BK * 2, STAGE_BYTES = 8 * HTB, NXCD = 8, WGM = 8;
__host__ __device__ __forceinline__ int lds_byte(int r, int c) { const int st = (r >> 4) * 2 + (c >> 5), rr = r & 15, cc = c & 31, ob = rr * 64 + cc * 2; return st * 1024 + (ob ^ (((ob >> 9) & 1) << 5)); }
__host__ __device__ __forceinline__ void stage_rc(int b, int& R, int& C) { const int st = b / 1024, sb = b % 1024, swz = sb ^ (((sb >> 9) & 1) << 5); R = (st >> 1) * 16 + swz / 64; C = (st & 1) * 32 + (swz % 64) / 2; }
__host__ __device__ __forceinline__ int perm32(int rho) { const int n = rho >> 4, i = rho & 15; return 8 * (i >> 2) + 4 * n + (i & 3); }
struct Unit { int pm, pn; };
struct Gemm { const h16* A; const h16* Bt; int M, N, K; };
struct StaticOrder {
    int nM, nN, nwg, G, c;
    __host__ __device__ void init(int M, int N, int G_, int c_) { nM = M / BM; nN = N / BM; nwg = nM * nN; G = G_; c = c_; }
    __host__ __device__ bool next(int i, Unit& u) const {
        const long L = (long)i * G + c; if (L >= nwg) return false;
        int wgid = (int)L; { const int q = nwg / NXCD, r = nwg % NXCD, xcd = wgid % NXCD, off = wgid / NXCD; wgid = (xcd < r ? xcd * (q + 1) : r * (q + 1) + (xcd - r) * q) + off; }
        const int nig = WGM * nN, gid = wgid / nig, fm = gid * WGM, gsz = (nM - fm) < WGM ? (nM - fm) : WGM;
        u.pm = fm + ((wgid % nig) % gsz); u.pn = (wgid % nig) / gsz; return true;
    }
};
__device__ __forceinline__ f32x2 gelu_pk(f32x2 v) {
    const f32x2 av = __builtin_elementwise_abs(v), d = av * 0.2316418882f + 1.0f;
    f32x2 t; t.x = __builtin_amdgcn_rcpf(d.x); t.y = __builtin_amdgcn_rcpf(d.y);
    f32x2 q = t * 0.5307027145f + (-0.7265760135f); q = q * t + 0.7107068705f; q = q * t + (-0.142248368f); q = q * t + 0.127414796f; q = q * t;
    const f32x2 s = (v * v) * (-0.72134752044f);
    f32x2 e; e.x = __builtin_amdgcn_exp2f(s.x); e.y = __builtin_amdgcn_exp2f(s.y);
    const f32x2 m = v * (q * e), r = v - m;
    f32x2 o; o.x = v.x < 0.f ? m.x : r.x; o.y = v.y < 0.f ? m.y : r.y; return o;
}
__device__ __forceinline__ unsigned pk_h2(float lo, float hi) { typedef _Float16 h2 __attribute__((ext_vector_type(2))); h2 v; v.x = (h16)lo; v.y = (h16)hi; return __builtin_bit_cast(unsigned, v); }
__device__ __forceinline__ u32x4 pk_h8(f32x4 a, f32x4 b) { u32x4 w; w.x = pk_h2(a[0], a[1]); w.y = pk_h2(a[2], a[3]); w.z = pk_h2(b[0], b[1]); w.w = pk_h2(b[2], b[3]); return w; }

template <class Epi, bool ALIGN_EPI = true>
__device__ __forceinline__ void gemm_phase(PG8_LAS unsigned char* lds, const Gemm g, const StaticOrder& S, const Epi& E, const int g_wid) {
    int tid = TID(); asm volatile("" : "+v"(tid));
    const int wid = __builtin_amdgcn_readfirstlane(tid >> 6), lane = tid & 63, wr = wid >> 2, wc = wid & 3, fr = lane & 15, fq = lane >> 4;
    const int K = g.K, nt = K / BK;
    unsigned voffA[2], voffB[2];
#pragma unroll
    for (int i = 0; i < 2; ++i) { int R, C; stage_rc(tid * 16 + i * 8192, R, C); const int Rb = (R & ~31) + perm32(R & 31);
        voffA[i] = (unsigned)(R * K + C) * 2u; voffB[i] = (unsigned)(Rb * K + C) * 2u; }
    const size_t kstep = (size_t)(BK * 2);
    const size_t hstep = (size_t)HALF * K * 2;
    const size_t tstep = 2 * hstep;
    const unsigned ldsw = (unsigned)wid * 1024u;
    const int aoff = lds_byte(wr * 64 + fr, fq * 8), boff = lds_byte(wc * 32 + fr, fq * 8);
#define PG8_SA(b, h) (((b) * 2 + (h)) * HTB)
#define PG8_SB(b, h) ((4 + (b) * 2 + (h)) * HTB)
#define PG8_STAGE(bufoff, gbase, voff) do { _Pragma("unroll") for (int _i = 0; _i < 2; ++_i) \
        __builtin_amdgcn_global_load_lds((const unsigned*)((const char*)(gbase) + (voff)[_i]), (PG8_LAS unsigned*)(lds + (bufoff) + ldsw + _i * 8192), 16, 0, 0); } while (0)
#define PG8_LDA(dst, b, h) do { _Pragma("unroll") for (int m = 0; m < 4; ++m) _Pragma("unroll") for (int k = 0; k < 2; ++k) dst[m][k] = *(const PG8_LAS h16x8*)(lds + PG8_SA(b, h) + aoff + m * 2048 + k * 1024); } while (0)
#define PG8_LDB(dst, b, h) do { _Pragma("unroll") for (int n = 0; n < 2; ++n) _Pragma("unroll") for (int k = 0; k < 2; ++k) dst[n][k] = *(const PG8_LAS h16x8*)(lds + PG8_SB(b, h) + boff + n * 2048 + k * 1024); } while (0)
#define PG8_MMA(ai, bj, At, Bt) do { __builtin_amdgcn_s_setprio(1); _Pragma("unroll") for (int m = 0; m < 4; ++m) _Pragma("unroll") for (int n = 0; n < 2; ++n) _Pragma("unroll") for (int k = 0; k < 2; ++k) \
        acc[ai][bj][m][n] = __builtin_amdgcn_mfma_f32_16x16x32_f16(Bt[n][k], At[m][k], acc[ai][bj][m][n], 0, 0, 0); __builtin_amdgcn_s_setprio(0); } while (0)
#define PG8_WAIT_V(n) asm volatile("s_waitcnt vmcnt(" #n ")" ::: "memory")
#define PG8_WAIT_L(n) asm volatile("s_waitcnt lgkmcnt(" #n ")" ::: "memory")
#define PG8_BAR __builtin_amdgcn_s_barrier()
#define PG8_SCHED __builtin_amdgcn_sched_barrier(0)
    Unit cur, nxt; int ui = 0;
    if (!S.next(0, cur)) return;
    f32x4 acc[2][2][4][2];
#pragma unroll
    for (int a = 0; a < 2; ++a)
#pragma unroll
        for (int b = 0; b < 2; ++b)
#pragma unroll
            for (int m = 0; m < 4; ++m)
#pragma unroll
                for (int n = 0; n < 2; ++n) acc[a][b][m][n] = (f32x4){0.f, 0.f, 0.f, 0.f};
    h16x8 At[4][2], B0[2][2], B1[2][2];
    const char* cA = (const char*)g.A + (size_t)cur.pm * tstep; const char* cB = (const char*)g.Bt + (size_t)cur.pn * tstep;
    PG8_STAGE(PG8_SB(0, 0), cB, voffB); PG8_STAGE(PG8_SB(0, 1), cB + hstep, voffB); PG8_STAGE(PG8_SA(0, 0), cA, voffA); PG8_STAGE(PG8_SA(0, 1), cA + hstep, voffA);
    if (wr == 1) PG8_BAR;
    PG8_WAIT_V(2); PG8_BAR;
    PG8_STAGE(PG8_SB(1, 0), cB + kstep, voffB); PG8_STAGE(PG8_SA(1, 0), cA + kstep, voffA); PG8_STAGE(PG8_SB(1, 1), cB + hstep + kstep, voffB);
    PG8_WAIT_V(6); PG8_BAR;
    for (;;) {
        const bool has_next = S.next(ui + 1, nxt);
        const char* nA = has_next ? (const char*)g.A + (size_t)nxt.pm * tstep : cA; const char* nB = has_next ? (const char*)g.Bt + (size_t)nxt.pn * tstep : cB;
#pragma unroll 1
        for (int t = 0; t < nt; t += 2) {
            const bool last = (t == nt - 2);
            const char* a1 = cA + (size_t)(t + 1) * kstep;
            const char* a2 = last ? nA : cA + (size_t)(t + 2) * kstep; const char* b2 = last ? nB : cB + (size_t)(t + 2) * kstep;
            const char* a3 = a2 + kstep; const char* b3 = b2 + kstep;
            PG8_LDB(B0, 0, 0); PG8_LDB(B1, 0, 1); PG8_SCHED; PG8_LDA(At, 0, 0); PG8_STAGE(PG8_SA(1, 1), a1 + hstep, voffA);
            PG8_WAIT_V(8); PG8_WAIT_L(0); PG8_BAR; PG8_MMA(0, 0, At, B0); PG8_MMA(0, 1, At, B1); PG8_BAR; PG8_SCHED;
            PG8_LDA(At, 0, 1); PG8_STAGE(PG8_SB(0, 0), b2, voffB); PG8_STAGE(PG8_SB(0, 1), b2 + hstep, voffB); PG8_STAGE(PG8_SA(0, 0), a2, voffA);
            PG8_WAIT_V(8); PG8_WAIT_L(0); PG8_BAR; PG8_MMA(1, 0, At, B0); PG8_MMA(1, 1, At, B1); PG8_BAR; PG8_SCHED;
            PG8_LDB(B0, 1, 0); PG8_LDB(B1, 1, 1); PG8_SCHED; PG8_LDA(At, 1, 0); PG8_STAGE(PG8_SA(0, 1), a2 + hstep, voffA);
            PG8_WAIT_V(8); PG8_WAIT_L(0); PG8_BAR; PG8_MMA(0, 0, At, B0); PG8_MMA(0, 1, At, B1); PG8_BAR; PG8_SCHED;
            PG8_LDA(At, 1, 1); PG8_STAGE(PG8_SB(1, 0), b3, voffB); PG8_STAGE(PG8_SB(1, 1), b3 + hstep, voffB); PG8_STAGE(PG8_SA(1, 0), a3, voffA);
            PG8_WAIT_V(8); PG8_WAIT_L(0); PG8_BAR; PG8_MMA(1, 0, At, B0); PG8_MMA(1, 1, At, B1); PG8_BAR; PG8_SCHED;
        }
        if constexpr (ALIGN_EPI) { if (wr == 0) PG8_BAR; }
        { int fr_ = fr, fq_ = fq; asm volatile("" : "+v"(fr_), "+v"(fq_));
          E(acc, cur, wr, wc, fr_, fq_); }
        if (!has_next) break;
#pragma unroll
        for (int a = 0; a < 2; ++a)
#pragma unroll
            for (int b = 0; b < 2; ++b)
#pragma unroll
                for (int m = 0; m < 4; ++m)
#pragma unroll
                    for (int n = 0; n < 2; ++n) acc[a][b][m][n] = (f32x4){0.f, 0.f, 0.f, 0.f};
        cur = nxt; cA = nA; cB = nB; ++ui;
        if constexpr (ALIGN_EPI) { if (wr == 1) PG8_BAR; }
    }
    PG8_WAIT_V(0);
    if constexpr (!ALIGN_EPI) { if (wr == 0) PG8_BAR; }
    PG8_BAR;
#undef PG8_SA
#undef PG8_SB
#undef PG8_STAGE
#undef PG8_LDA
#undef PG8_LDB
#undef PG8_MMA
#undef PG8_WAIT_V
#undef PG8_WAIT_L
#undef PG8_BAR
#undef PG8_SCHED
}

struct EpiOut {
    h16* Y; float* ssy;
    __device__ __forceinline__ void operator()(const f32x4 (&acc)[2][2][4][2], const Unit& u, int wr, int wc, int fr, int fq) const {
        const int row0 = u.pm * BM + wr * 64 + fr, col0 = u.pn * BM + wc * 32 + 8 * fq;
#pragma unroll
        for (int ai = 0; ai < 2; ++ai)
#pragma unroll
            for (int m = 0; m < 4; ++m) { const int row = row0 + ai * HALF + m * 16; h16* rowp = Y + (size_t)row * DM + col0; float s = 0.f;
#pragma unroll
                for (int bj = 0; bj < 2; ++bj) { const f32x4 v0 = acc[ai][bj][m][0], v1 = acc[ai][bj][m][1];
                    s += (v0[0] * v0[0] + v0[1] * v0[1]) + (v0[2] * v0[2] + v0[3] * v0[3]) + (v1[0] * v1[0] + v1[1] * v1[1]) + (v1[2] * v1[2] + v1[3] * v1[3]);
                    *(u32x4*)(rowp + bj * HALF) = pk_h8(v0, v1); }
                s += __shfl_xor(s, 16); s += __shfl_xor(s, 32);
                if (fq == 0) atomicAdd(ssy + row, s); }
    }
};

__device__ __forceinline__ float silu_f(float v) { return v * __builtin_amdgcn_rcpf(1.0f + __builtin_amdgcn_exp2f(-1.4426950408889634f * v)); }
struct EpiProj {
    h16 *U, *V, *ZA, *ZB, *CQ, *KV, *KIDX; float *CKVR, *WIDX, *ssq, *sskv; const float* rope;
    __device__ __forceinline__ void operator()(const f32x4 (&acc)[2][2][4][2], const Unit& u, int wr, int wc, int fr, int fq) const {
        const int row0 = u.pm * BM + wr * 64 + fr, pn = u.pn;
        if (pn < 8) {
            h16* base = (pn < 2 ? U : pn < 4 ? V : pn < 6 ? ZA : ZB) + (pn & 1) * 256 + wc * 32 + 8 * fq;
#pragma unroll
            for (int ai = 0; ai < 2; ++ai)
#pragma unroll
                for (int m = 0; m < 4; ++m) { h16* rowp = base + (size_t)(row0 + ai * HALF + m * 16) * GW;
#pragma unroll
                    for (int bj = 0; bj < 2; ++bj) *(u32x4*)(rowp + bj * HALF) = pk_h8(acc[ai][bj][m][0], acc[ai][bj][m][1]); }
        } else if (pn == 8) {
            const int col0 = wc * 32 + 8 * fq;
#pragma unroll
            for (int ai = 0; ai < 2; ++ai)
#pragma unroll
                for (int m = 0; m < 4; ++m) { const int row = row0 + ai * HALF + m * 16; h16* rowp = CQ + (size_t)row * QR + col0; float s = 0.f;
#pragma unroll
                    for (int bj = 0; bj < 2; ++bj) { const f32x4 v0 = acc[ai][bj][m][0], v1 = acc[ai][bj][m][1];
                        s += (v0[0] * v0[0] + v0[1] * v0[1]) + (v0[2] * v0[2] + v0[3] * v0[3]) + (v1[0] * v1[0] + v1[1] * v1[1]) + (v1[2] * v1[2] + v1[3] * v1[3]);
                        *(u32x4*)(rowp + bj * HALF) = pk_h8(v0, v1); }
                    s += __shfl_xor(s, 16); s += __shfl_xor(s, 32);
                    if (fq == 0) atomicAdd(ssq + row, s); }
        } else {
#pragma unroll
            for (int ai = 0; ai < 2; ++ai)
#pragma unroll
                for (int m = 0; m < 4; ++m) { const int row = row0 + ai * HALF + m * 16;
                    { const f32x4 v0 = acc[ai][0][m][0], v1 = acc[ai][0][m][1];
                        float s = (v0[0] * v0[0] + v0[1] * v0[1]) + (v0[2] * v0[2] + v0[3] * v0[3]) + (v1[0] * v1[0] + v1[1] * v1[1]) + (v1[2] * v1[2] + v1[3] * v1[3]);
                        float* p = CKVR + (size_t)row * CKV + wc * 32 + 8 * fq; *(f32x4*)p = v0; *(f32x4*)(p + 4) = v1;
                        s += __shfl_xor(s, 16); s += __shfl_xor(s, 32);
                        if (fq == 0) atomicAdd(sskv + row, s); }
                    const f32x4 x1 = acc[ai][1][m][0], x2 = acc[ai][1][m][1];
                    if (wc == 0) {
                        const int pos = row & (SEQ - 1); const float* rp = rope + (size_t)pos * 32 + 8 * fq;
                        const f32x4 r0 = *(const f32x4*)rp, r1 = *(const f32x4*)(rp + 4);
                        const float o1a = x1[0] * r0[0] - x2[0] * r0[1], o2a = x2[0] * r0[0] + x1[0] * r0[1];
                        const float o1b = x1[1] * r0[2] - x2[1] * r0[3], o2b = x2[1] * r0[2] + x1[1] * r0[3];
                        const float o1c = x1[2] * r1[0] - x2[2] * r1[1], o2c = x2[2] * r1[0] + x1[2] * r1[1];
                        const float o1d = x1[3] * r1[2] - x2[3] * r1[3], o2d = x2[3] * r1[2] + x1[3] * r1[3];
                        h16* p = KV + (size_t)row * KVD + CKV + 4 * fq;
                        typedef unsigned u32x2 __attribute__((ext_vector_type(2)));
                        *(u32x2*)p = (u32x2){pk_h2(o1a, o1b), pk_h2(o1c, o1d)}; *(u32x2*)(p + 16) = (u32x2){pk_h2(o2a, o2b), pk_h2(o2c, o2d)};
                    } else if (wc < 3) {
                        *(u32x4*)(KIDX + (size_t)row * IDXD + (wc - 1) * 32 + 8 * fq) = pk_h8(x1, x2);
                    } else if (fq == 0) {
                        float* p = WIDX + (size_t)row * NH; *(f32x4*)p = x1 * 0.044194173824159216f; *(f32x4*)(p + 4) = x2 * 0.044194173824159216f;
                    } }
        }
    }
};

struct EpiQ {
    h16 *QA, *QIDX; const float* ssq; const float* rope;
    template <int RS, int BS>
    __device__ __forceinline__ void plain(const f32x4 (&acc)[2][2][4][2], h16* base, int row0) const {
#pragma unroll
        for (int ai = 0; ai < 2; ++ai)
#pragma unroll
            for (int m = 0; m < 4; ++m) { const int row = row0 + ai * HALF + m * 16; const float rstd = rsqrtf(ssq[row] * (1.f / QR) + EPS);
                h16* rowp = base + (size_t)row * RS;
#pragma unroll
                for (int bj = 0; bj < 2; ++bj) *(u32x4*)(rowp + bj * BS) = pk_h8(acc[ai][bj][m][0] * rstd, acc[ai][bj][m][1] * rstd);
                asm volatile("" ::: "memory"); }
    }
    __device__ __forceinline__ void operator()(const f32x4 (&acc)[2][2][4][2], const Unit& u, int wr, int wc, int fr, int fq) const {
        const int row0 = u.pm * BM + wr * 64 + fr, pn = u.pn;
        if (pn < 4) plain<NH * KVD, KVD>(acc, QA + (2 * pn) * KVD + wc * 32 + 8 * fq, row0);
        else if (pn < 6) plain<512, HALF>(acc, QIDX + (pn - 4) * 256 + wc * 32 + 8 * fq, row0);
        else {
#pragma unroll
            for (int ai = 0; ai < 2; ++ai)
#pragma unroll
                for (int m = 0; m < 4; ++m) { const int row = row0 + ai * HALF + m * 16; const float rstd = rsqrtf(ssq[row] * (1.f / QR) + EPS);
                    const int pos = row & (SEQ - 1); const float* rp = rope + (size_t)pos * 32 + 8 * fq;
                    const f32x4 r0 = *(const f32x4*)rp * rstd, r1 = *(const f32x4*)(rp + 4) * rstd;
#pragma unroll
                    for (int bj = 0; bj < 2; ++bj) { const f32x4 v0 = acc[ai][bj][m][0], v1 = acc[ai][bj][m][1];
                        const float o1a = v0[0] * r0[0] - v1[0] * r0[1], o2a = v1[0] * r0[0] + v0[0] * r0[1];
                        const float o1b = v0[1] * r0[2] - v1[1] * r0[3], o2b = v1[1] * r0[2] + v0[1] * r0[3];
                        const float o1c = v0[2] * r1[0] - v1[2] * r1[1], o2c = v1[2] * r1[0] + v0[2] * r1[1];
                        const float o1d = v0[3] * r1[2] - v1[3] * r1[3], o2d = v1[3] * r1[2] + v0[3] * r1[3];
                        h16* p = QA + (size_t)row * (NH * KVD) + (4 * bj + wc) * KVD + CKV + 4 * fq;
                        typedef unsigned u32x2 __attribute__((ext_vector_type(2)));
                        *(u32x2*)p = (u32x2){pk_h2(o1a, o1b), pk_h2(o1c, o1d)}; *(u32x2*)(p + 16) = (u32x2){pk_h2(o2a, o2b), pk_h2(o2c, o2d)}; }
                    asm volatile("" ::: "memory"); }
        }
    }
};
}

constexpr int NTHREADS = 512;
constexpr int LDS_BYTES = 147456;


__device__ __forceinline__ void ckvnorm_phase(const Args& a, const int g_wid) {
    int tid_ = TID(); asm volatile("" : "+v"(tid_));
    unsigned char* ws = a.ws; const float* CKVR = (const float*)(ws + WS_CKVR); const float* sskv = (const float*)(ws + WS_SSKV); h16* KV = (h16*)(ws + WS_KV);
    { const h16* KIDX = (const h16*)(ws + WS_KIDX); unsigned* kmax = (unsigned*)(ws + WS_KMAX);
      for (int tok = blockIdx.x * blockDim.x + tid_; tok < T; tok += gridDim.x * blockDim.x) { float s = 0.f;
        for (int e = 0; e < 8; ++e) { const h16x8 v = *(const h16x8*)(KIDX + (size_t)tok * IDXD + 8 * e); for (int k = 0; k < 8; ++k) s += (float)v[k] * (float)v[k]; }
        for (int o = 1; o < 64; o <<= 1) s = fmaxf(s, __shfl_xor(s, o));
        if ((tid_ & 63) == 0) atomicMax(kmax + tok / SEQ, __float_as_uint(s)); } }
    for (int i = blockIdx.x * blockDim.x + tid_; i < T * 16; i += gridDim.x * blockDim.x) {
        const int tok = i >> 4, c = (i & 15) * 8; const float rstd = rsqrtf(sskv[tok] * (1.f / CKV) + EPS);
        const f32x4 v0 = *(const f32x4*)(CKVR + (size_t)tok * CKV + c), v1 = *(const f32x4*)(CKVR + (size_t)tok * CKV + c + 4);
        const f32x4 g0 = *(const f32x4*)(a.kvn_g + c), g1 = *(const f32x4*)(a.kvn_g + c + 4);
        *(pg8::u32x4*)(KV + (size_t)tok * KVD + c) = pg8::pk_h8(v0 * rstd * g0, v1 * rstd * g1);
    }
}


namespace p3 {
#define LAS __attribute__((address_space(3)))
typedef float f32x16 __attribute__((ext_vector_type(16)));
typedef short s16x4 __attribute__((ext_vector_type(4)));
typedef unsigned u32x4 __attribute__((ext_vector_type(4)));
typedef unsigned u32x2 __attribute__((ext_vector_type(2)));
constexpr int CC = 96;
constexpr int L_SEL = 0;
constexpr int L_META = 16384;
constexpr int L_WQ = L_META + 1024;
constexpr int L_QN = L_WQ + 1024;
constexpr int L_MISC = L_QN + 1024;
constexpr int L_QS = 20480, QS_STRIDE = 1040;
constexpr int L_HIST = L_QS + 32 * QS_STRIDE;
constexpr int L_CAND = L_HIST + 65536;
constexpr int L_VBUF = 20480;
constexpr int L_OLAT = L_VBUF + 65536, OL_STRIDE = 2064;
constexpr int L_END = L_OLAT + 32 * OL_STRIDE;
static_assert(L_CAND + 32 * CC * 8 <= L_END, "lds map");

__device__ __forceinline__ float med3(float a, float b, float c) { return __builtin_amdgcn_fmed3f(a, b, c); }

constexpr unsigned KBASE = 0x3C000000u >> 7;
constexpr unsigned K1 = (512u << 10) - KBASE, K2 = (512u << 10) - 1u + KBASE;
__device__ __forceinline__ float relu_i(float x) { const int b = __builtin_bit_cast(int, x); return __builtin_bit_cast(float, b > 0 ? b : 0); }
#define P3_QRD(dst, off) asm volatile("ds_read_b128 %0, %1 offset:%2" : "=v"(dst) : "v"(qaddr), "i"(off))
__device__ __forceinline__ void index_pass(LAS unsigned char* lds, const h16* kb, int np64, int wid, int lane, float* scache) {
    asm volatile("" : "+v"(lane));
    const int r = lane & 31, hh = lane >> 5;
    float w[8];
    { const f32x4 w0 = *(const LAS f32x4*)(lds + L_WQ + r * 32), w1 = *(const LAS f32x4*)(lds + L_WQ + r * 32 + 16);
      w[0] = w0[0]; w[1] = w0[1]; w[2] = w0[2]; w[3] = w0[3]; w[4] = w1[0]; w[5] = w1[1]; w[6] = w1[2]; w[7] = w1[3]; }
    const float sp = *(const LAS float*)(lds + L_META + r * 4), sn = *(const LAS float*)(lds + L_META + 128 + r * 4);
    const unsigned qaddr = (unsigned)(uintptr_t)(lds + L_QS + r * QS_STRIDE + hh * 16);
    LAS unsigned char* hist = lds + L_HIST + r * 2048;
    h16x8 a0[4], a1[4];
    int pp = wid;
    if (pp < np64) { const h16* kp = kb + (size_t)(pp * 64 + r) * IDXD + hh * 8;
#pragma unroll
        for (int ks = 0; ks < 4; ++ks) { a0[ks] = *(const h16x8*)(kp + 16 * ks); a1[ks] = *(const h16x8*)(kp + 32 * IDXD + 16 * ks); } }
    for (; pp < np64; pp += 8) {
        f32x16 sc0, sc1, cA0, cA1, cB0, cB1;
#pragma unroll
        for (int i = 0; i < 16; ++i) { sc0[i] = 0.f; sc1[i] = 0.f; cA0[i] = 0.f; cA1[i] = 0.f; }
        h16x8 bA[4], bB[4];
        P3_QRD(bA[0], 0); P3_QRD(bA[1], 32); P3_QRD(bA[2], 64); P3_QRD(bA[3], 96);
        P3_QRD(bB[0], 128); P3_QRD(bB[1], 160); P3_QRD(bB[2], 192); P3_QRD(bB[3], 224);
        asm volatile("s_waitcnt lgkmcnt(0)" ::: "memory"); __builtin_amdgcn_sched_barrier(0);
#pragma unroll
        for (int ks = 0; ks < 4; ++ks) { cA0 = __builtin_amdgcn_mfma_f32_32x32x16_f16(a0[ks], bA[ks], cA0, 0, 0, 0); cA1 = __builtin_amdgcn_mfma_f32_32x32x16_f16(a1[ks], bA[ks], cA1, 0, 0, 0); }
#define P3_R(h, cC0, cC1, cN0, cN1, bufC, bufN) do { \
            if ((h) < 7) { _Pragma("unroll") for (int i = 0; i < 16; ++i) { cN0[i] = 0.f; cN1[i] = 0.f; } \
                _Pragma("unroll") for (int ks = 0; ks < 4; ++ks) { cN0 = __builtin_amdgcn_mfma_f32_32x32x16_f16(a0[ks], bufN[ks], cN0, 0, 0, 0); cN1 = __builtin_amdgcn_mfma_f32_32x32x16_f16(a1[ks], bufN[ks], cN1, 0, 0, 0); } } \
            if ((h) < 6) { P3_QRD(bufC[0], ((h) + 2) * 128); P3_QRD(bufC[1], ((h) + 2) * 128 + 32); P3_QRD(bufC[2], ((h) + 2) * 128 + 64); P3_QRD(bufC[3], ((h) + 2) * 128 + 96); } \
            if ((h) == 7) { const int pn_ = (pp + 8 < np64) ? pp + 8 : pp; const h16* kp = kb + (size_t)(pn_ * 64 + r) * IDXD + hh * 8;     \
                _Pragma("unroll") for (int ks = 0; ks < 4; ++ks) { a0[ks] = *(const h16x8*)(kp + 16 * ks); a1[ks] = *(const h16x8*)(kp + 32 * IDXD + 16 * ks); } } \
            _Pragma("unroll") for (int i = 0; i < 16; ++i) { const float r0_ = relu_i(cC0[i]), r1_ = relu_i(cC1[i]); \
                asm("v_fmac_f32 %0, %1, %2" : "+v"(sc0[i]) : "v"(w[h]), "v"(r0_)); asm("v_fmac_f32 %0, %1, %2" : "+v"(sc1[i]) : "v"(w[h]), "v"(r1_)); }     \
            asm volatile("" : "+v"(sc0), "+v"(sc1));     \
            if ((h) < 6) asm volatile("s_waitcnt lgkmcnt(0)" ::: "memory"); \
            __builtin_amdgcn_sched_barrier(0); } while (0)
        P3_R(0, cA0, cA1, cB0, cB1, bA, bB); P3_R(1, cB0, cB1, cA0, cA1, bB, bA); P3_R(2, cA0, cA1, cB0, cB1, bA, bB); P3_R(3, cB0, cB1, cA0, cA1, bB, bA);
        P3_R(4, cA0, cA1, cB0, cB1, bA, bB); P3_R(5, cB0, cB1, cA0, cA1, bB, bA); P3_R(6, cA0, cA1, cB0, cB1, bA, bB); P3_R(7, cB0, cB1, cA0, cA1, bB, bA);
#undef P3_R
        { float* sp_ = scache + (size_t)r * SEQ + pp * 64 + 4 * hh;
#pragma unroll
          for (int g4 = 0; g4 < 4; ++g4) { *(f32x4*)(sp_ + 8 * g4) = (f32x4){sc0[4 * g4], sc0[4 * g4 + 1], sc0[4 * g4 + 2], sc0[4 * g4 + 3]};
                                           *(f32x4*)(sp_ + 32 + 8 * g4) = (f32x4){sc1[4 * g4], sc1[4 * g4 + 1], sc1[4 * g4 + 2], sc1[4 * g4 + 3]}; } }
#pragma unroll
        for (int half = 0; half < 2; ++half)
#pragma unroll
        for (int i = 0; i < 16; ++i) {
            const float sc = half ? sc1[i] : sc0[i]; const int mask = __builtin_bit_cast(int, sc) >> 31;
            const float scl = __builtin_bit_cast(float, (mask & __builtin_bit_cast(int, sn)) | (~mask & __builtin_bit_cast(int, sp)));
            const float v = __builtin_fmaf(__builtin_fabsf(sc), scl, 0.0078125f);
            const unsigned ck = (((__float_as_uint(v) >> 7) - KBASE) ^ (unsigned)mask) + (512u << 10);
            __hip_atomic_fetch_add((LAS unsigned*)(hist + ((ck >> 8) & 0x7fcu)), (unsigned)((mask & 1) | (~mask & 65536)), __ATOMIC_RELAXED, __HIP_MEMORY_SCOPE_WORKGROUP);
            if ((i & 3) == 3) __builtin_amdgcn_sched_barrier(0);
        }
    }
}
#undef P3_QRD

__device__ __forceinline__ void find_thr(LAS unsigned char* lds, int q, unsigned need, int lane, int& tbin, unsigned& nabove, unsigned& nin) {
    const LAS u32x4* hq = (const LAS u32x4*)(lds + L_HIST + q * 2048 + lane * 32); const u32x4 wa = hq[0], wb = hq[1];
    const unsigned wv[8] = {wa[0], wa[1], wa[2], wa[3], wb[0], wb[1], wb[2], wb[3]}; unsigned totH = 0, totL = 0;
#pragma unroll
    for (int e = 0; e < 8; ++e) { totH += wv[e] >> 16; totL += wv[e] & 0xffffu; }
    unsigned sH = totH, sL = totL;
#pragma unroll
    for (int o = 1; o < 64; o <<= 1) { const unsigned t = __shfl_down(sH, o), u = __shfl_down(sL, o); if (lane + o < 64) { sH += t; sL += u; } }
    const unsigned allH = __shfl(sH, 0);
    const bool inH = allH >= need;
    const unsigned nd = inH ? need : need - allH, base = inH ? 0u : allH, sfx = inH ? sH : sL, tot = inH ? totH : totL;
    const unsigned long long bal = __ballot(sfx >= nd);
    const int L = bal ? 63 - __builtin_clzll(bal) : 0;
    unsigned above = base + sfx - tot, nab = above, ni = 0; bool found = false; int tb = 8 * lane;
#pragma unroll
    for (int e = 7; e >= 0; --e) { const unsigned c = inH ? (wv[e] >> 16) : (wv[e] & 0xffffu);
        if (!found && above + c >= need) { found = true; tb = 8 * lane + e; nab = above; ni = c; }
        if (!found) above += c; }
    tbin = __shfl(tb, L) + (inH ? 512 : 0); nabove = __shfl(nab, L); nin = __shfl(ni, L);
}

__device__ __forceinline__ unsigned ck_of(float sc, float sp, float sn) {
    const int mask = __builtin_bit_cast(int, sc) >> 31;
    const float scl = __builtin_bit_cast(float, (mask & __builtin_bit_cast(int, sn)) | (~mask & __builtin_bit_cast(int, sp)));
    const float v = __builtin_fmaf(__builtin_fabsf(sc), scl, 0.0078125f);
    return (((__float_as_uint(v) >> 7) - KBASE) ^ (unsigned)mask) + (512u << 10);
}
__device__ __forceinline__ float thr_to_float(unsigned T, float sp, float sn) {
    if (T >= (512u << 10)) {
        if (!(sp > 0.f)) return __builtin_inff();
        unsigned lo = 0u, hi = __float_as_uint(1.5f / sp);
        if (ck_of(__uint_as_float(hi), sp, sn) < T) return __builtin_inff();
#pragma unroll 1
        for (int it = 0; it < 32; ++it) { const unsigned mid = lo + ((hi - lo) >> 1); if (ck_of(__uint_as_float(mid), sp, sn) >= T) hi = mid; else lo = mid + 1u; if (lo >= hi) break; }
        return __uint_as_float(hi);
    } else {
        if (!(sn > 0.f)) return -0.0f;
        unsigned lo = 0u, hi = __float_as_uint(1.5f / sn);
#pragma unroll 1
        for (int it = 0; it < 32; ++it) { if (lo >= hi) break; const unsigned mid = lo + ((hi - lo + 1u) >> 1); if (ck_of(-__uint_as_float(mid), sp, sn) >= T) lo = mid; else hi = mid - 1u; }
        return -__uint_as_float(lo);
    }
}
template <int MODE>
__device__ __forceinline__ void scan_q(LAS unsigned char* lds, const float* scache, int N, int q, int lane, unsigned tbin, float flo, float fhi, float spq, float snq) {
    const float* row = scache + (size_t)q * SEQ + 4 * lane;
    LAS unsigned* selc = (LAS unsigned*)(lds + L_META + 512 + q * 4); LAS unsigned* canc = (LAS unsigned*)(lds + L_META + 640 + q * 4);
    const float ninf = -__builtin_inff();
    f32x4 nx[4];
#pragma unroll
    for (int u = 0; u < 4; ++u) nx[u] = (256 * u + 4 * lane < N) ? *(const f32x4*)(row + 256 * u) : (f32x4){ninf, ninf, ninf, ninf};
    for (int k0 = 0; k0 < N; k0 += 1024) {
        f32x4 sv[4];
#pragma unroll
        for (int u = 0; u < 4; ++u) sv[u] = nx[u];
#pragma unroll
        for (int u = 0; u < 4; ++u) nx[u] = (k0 + 1024 + 256 * u + 4 * lane < N) ? *(const f32x4*)(row + k0 + 1024 + 256 * u) : (f32x4){ninf, ninf, ninf, ninf};
#pragma unroll
        for (int u = 0; u < 4; ++u) {
            const int key0 = k0 + 256 * u + 4 * lane; const f32x4 s4 = sv[u];
            if (MODE == 4) { asm volatile("" :: "v"(s4)); continue; }
            if (MODE == 2) {
#pragma unroll
                for (int j = 0; j < 4; ++j) { const unsigned ck = ck_of(s4[j], spq, snq);
                    if ((ck >> 10) == tbin && s4[j] > ninf) __hip_atomic_fetch_add((LAS unsigned*)(lds + L_HIST + q * 2048 + ((ck << 2) & 0x7fcu)), (ck & 512u) ? 65536u : 1u, __ATOMIC_RELAXED, __HIP_MEMORY_SCOPE_WORKGROUP); }
                continue; }
            unsigned long long bh[4]; unsigned tot = 0; bool anyc = false;
#pragma unroll
            for (int j = 0; j < 4; ++j) { bh[j] = __ballot(s4[j] >= fhi); tot += (unsigned)__builtin_popcountll(bh[j]); anyc |= (s4[j] >= flo) && !(s4[j] >= fhi); }
            if (tot) {
                unsigned base = 0; if (lane == 0) base = __hip_atomic_fetch_add(selc, tot, __ATOMIC_RELAXED, __HIP_MEMORY_SCOPE_WORKGROUP);
                base = (unsigned)__builtin_amdgcn_readfirstlane((int)base);
#pragma unroll
                for (int j = 0; j < 4; ++j) { const unsigned off = __builtin_amdgcn_mbcnt_hi((unsigned)(bh[j] >> 32), __builtin_amdgcn_mbcnt_lo((unsigned)bh[j], 0u));
                    if (s4[j] >= fhi && base + off < 256u) ((LAS unsigned short*)(lds + L_SEL))[q * 256 + base + off] = (unsigned short)(key0 + j);
                    base += (unsigned)__builtin_popcountll(bh[j]); }
            }
            if (anyc) {
#pragma unroll
                for (int j = 0; j < 4; ++j) if (s4[j] >= flo && !(s4[j] >= fhi)) { const unsigned pc = __hip_atomic_fetch_add(canc, 1u, __ATOMIC_RELAXED, __HIP_MEMORY_SCOPE_WORKGROUP);
                    if (pc < (unsigned)CC) ((LAS u32x2*)(lds + L_CAND))[q * CC + pc] = (u32x2){__float_as_uint(s4[j]), (unsigned)(key0 + j)}; }
            }
        }
    }
}

template <int AMODE = 0>
__device__ __forceinline__ void attn_query(LAS unsigned char* lds, const h16* qa, const h16* kvb, int qi, int cnt, int wid, int lane) {
    asm volatile("" : "+v"(lane));
    const int c15 = lane & 15, g = lane >> 4, k7 = c15 & 7;
    h16x8 qb[5];
#pragma unroll
    for (int ks = 0; ks < 5; ++ks) { h16x8 z; for (int e = 0; e < 8; ++e) z[e] = (h16)0.f; qb[ks] = c15 < 8 ? *(const h16x8*)(qa + c15 * KVD + 32 * ks + 8 * g) : z; }
    f32x4 o[8];
#pragma unroll
    for (int ct = 0; ct < 8; ++ct) o[ct] = (f32x4){0.f, 0.f, 0.f, 0.f};
    float m_run = -INFINITY, l_part = 0.f;
    const LAS unsigned short* sel = (const LAS unsigned short*)(lds + L_SEL) + qi * 256;
    LAS unsigned char* vb = lds + L_VBUF + wid * 8192;
    LAS unsigned char* wrow = vb + c15 * 256;
    const int kt = 4 * g + (c15 >> 2), pp = c15 & 3;
    const unsigned trbase = (unsigned)(uintptr_t)(vb + kt * 256 + 16 * (pp >> 1) + 8 * (pp & 1));
    const int kt7 = kt & 7;
    const int nch = cnt >> 5;
    constexpr float SC = 0.10206207261596577f * 1.4426950408889634f;
    h16x8 n0[5], n1[5];
    { const int i0 = sel[c15], i1 = sel[16 + c15];
      const h16* r0 = kvb + (size_t)i0 * KVD + 8 * g; const h16* r1 = kvb + (size_t)i1 * KVD + 8 * g;
#pragma unroll
      for (int ks = 0; ks < 5; ++ks) { n0[ks] = *(const h16x8*)(r0 + 32 * ks); n1[ks] = *(const h16x8*)(r1 + 32 * ks); } }
    for (int c = 0; c < nch; ++c) {
        h16x8 a0[5], a1[5];
#pragma unroll
        for (int ks = 0; ks < 5; ++ks) { a0[ks] = n0[ks]; a1[ks] = n1[ks]; }
        if (AMODE != 1) { const int cn = (c + 1 < nch) ? c + 1 : c; const int i0 = sel[32 * cn + c15], i1 = sel[32 * cn + 16 + c15];
          const h16* r0 = kvb + (size_t)i0 * KVD + 8 * g; const h16* r1 = kvb + (size_t)i1 * KVD + 8 * g;
#pragma unroll
          for (int ks = 0; ks < 5; ++ks) { n0[ks] = *(const h16x8*)(r0 + 32 * ks); n1[ks] = *(const h16x8*)(r1 + 32 * ks); } }
        if (AMODE == 2) {
#pragma unroll
          for (int ks = 0; ks < 5; ++ks) { asm volatile("" :: "v"(a0[ks]), "v"(a1[ks])); }
          continue; }
#pragma unroll
        for (int ks = 0; ks < 4; ++ks) { const int ch = ((4 * ks + g) ^ (2 * k7)) << 4; *(LAS h16x8*)(wrow + ch) = a0[ks]; *(LAS h16x8*)(wrow + 4096 + ch) = a1[ks]; }
        f32x4 s0 = (f32x4){0.f, 0.f, 0.f, 0.f}, s1 = (f32x4){0.f, 0.f, 0.f, 0.f};
#pragma unroll
        for (int ks = 0; ks < 5; ++ks) { s0 = __builtin_amdgcn_mfma_f32_16x16x32_f16(a0[ks], qb[ks], s0, 0, 0, 0); s1 = __builtin_amdgcn_mfma_f32_16x16x32_f16(a1[ks], qb[ks], s1, 0, 0, 0); }
        s0 = s0 * SC; s1 = s1 * SC;
        float mx = fmaxf(fmaxf(fmaxf(s0[0], s0[1]), fmaxf(s0[2], s0[3])), fmaxf(fmaxf(s1[0], s1[1]), fmaxf(s1[2], s1[3])));
        mx = fmaxf(mx, __shfl_xor(mx, 16)); mx = fmaxf(mx, __shfl_xor(mx, 32));
        const float mn = fmaxf(m_run, mx), alpha = __builtin_amdgcn_exp2f(m_run - mn);
        f32x4 p0, p1;
#pragma unroll
        for (int e = 0; e < 4; ++e) { p0[e] = __builtin_amdgcn_exp2f(s0[e] - mn); p1[e] = __builtin_amdgcn_exp2f(s1[e] - mn); }
        l_part = l_part * alpha + ((p0[0] + p0[1]) + (p0[2] + p0[3])) + ((p1[0] + p1[1]) + (p1[2] + p1[3]));
        m_run = mn;
#pragma unroll
        for (int ct = 0; ct < 8; ++ct) o[ct] = o[ct] * alpha;
        h16x8 pb; pb[0] = (h16)p0[0]; pb[1] = (h16)p0[1]; pb[2] = (h16)p0[2]; pb[3] = (h16)p0[3]; pb[4] = (h16)p1[0]; pb[5] = (h16)p1[1]; pb[6] = (h16)p1[2]; pb[7] = (h16)p1[3];
        s16x4 lo[8], hi[8];
#pragma unroll
        for (int ct = 0; ct < 8; ++ct) { const unsigned ad = trbase + (unsigned)((ct ^ kt7) << 5);
            asm volatile("ds_read_b64_tr_b16 %0, %1" : "=&v"(lo[ct]) : "v"(ad) : "memory");
            asm volatile("ds_read_b64_tr_b16 %0, %1 offset:4096" : "=&v"(hi[ct]) : "v"(ad) : "memory"); }
        asm volatile("s_waitcnt lgkmcnt(0)" ::: "memory"); __builtin_amdgcn_sched_barrier(0);
#pragma unroll
        for (int ct = 0; ct < 8; ++ct) { const s16x4 l4 = lo[ct], h4 = hi[ct];
            typedef short s16x8 __attribute__((ext_vector_type(8)));
            const s16x8 va = (s16x8){l4[0], l4[1], l4[2], l4[3], h4[0], h4[1], h4[2], h4[3]};
            o[ct] = __builtin_amdgcn_mfma_f32_16x16x32_f16(__builtin_bit_cast(h16x8, va), pb, o[ct], 0, 0, 0); }
    }
    float l = l_part; l += __shfl_xor(l, 16); l += __shfl_xor(l, 32);
    const float inv = 1.0f / l;
    if (c15 < 8) {
        LAS unsigned char* op = lds + L_OLAT + qi * OL_STRIDE + c15 * 256 + 8 * g;
#pragma unroll
        for (int ct = 0; ct < 8; ++ct) { h16x4 v; v[0] = (h16)(o[ct][0] * inv); v[1] = (h16)(o[ct][1] * inv); v[2] = (h16)(o[ct][2] * inv); v[3] = (h16)(o[ct][3] * inv);
            *(LAS h16x4*)(op + 32 * ct) = v; }
    }
}

template <int REPSEL = 1, int REPATT = 1>
__device__ __forceinline__ void phase(LAS unsigned char* lds, unsigned char* ws, size_t qoff, const int g_wid) {
    const int wid = __builtin_amdgcn_readfirstlane(threadIdx.x >> 6);
    const h16* QIDX = (const h16*)(ws + WS_QIDX); const h16* KIDX = (const h16*)(ws + WS_KIDX); const float* WIDX = (const float*)(ws + WS_WIDX);
    const h16* QA = (const h16*)(ws + WS_QA); const h16* KV = (const h16*)(ws + WS_KV); const h16* WuvT = (const h16*)(ws + WS_WUVT);
    const h16* ZB = (const h16*)(ws + WS_ZB); h16* A2 = (h16*)(ws + WS_A2);
    unsigned* qctr = (unsigned*)(ws + WS_QUEUE + qoff); const unsigned* kmaxp = (const unsigned*)(ws + WS_KMAX);
    const int queue = blockIdx.x & 7, b = queue >> 1;
    LAS int* misc = (LAS int*)(lds + L_MISC);
    for (;;) {
        if (TID() == 0) misc[0] = (int)atomicAdd(qctr + queue * 64, 1u);
        __syncthreads();
        const int j = misc[0];
        if (j >= 128) break;
        int tid = TID(); asm volatile("" : "+v"(tid));
        const int lane = tid & 63;
        const int qt = 255 - 2 * j - (queue & 1), q0 = qt * 32, tok0 = b * SEQ + q0, N = ((q0 >> 6) + 1) * 64;
        for (int rep_ = 0; rep_ < REPSEL; ++rep_) {
        if (rep_) __syncthreads();
        for (int i = tid; i < 1024; i += NTHREADS) ((LAS u32x4*)(lds + L_SEL))[i] = (u32x4){0u, 0u, 0u, 0u};
        if (N <= TOPK) {
            __syncthreads();
            for (int i = tid; i < 32 * 256; i += NTHREADS) { const int jj = i & 255; if (jj < N) ((LAS unsigned short*)(lds + L_SEL))[i] = (unsigned short)jj; }
        } else {
            { const int q = tid >> 4, part = tid & 15; const h16* src_ = QIDX + (size_t)(tok0 + q) * 512 + part * 32; LAS unsigned char* dst = lds + L_QS + q * QS_STRIDE + part * 64;
#pragma unroll
              for (int e = 0; e < 4; ++e) *(LAS h16x8*)(dst + 16 * e) = *(const h16x8*)(src_ + 8 * e); }
            if (tid < 256) {
                const int q = tid >> 3, h = tid & 7; const h16* qp = QIDX + (size_t)(tok0 + q) * 512 + h * 64; float s2 = 0.f;
#pragma unroll
                for (int e = 0; e < 8; ++e) { const h16x8 v = *(const h16x8*)(qp + 8 * e);
#pragma unroll
                    for (int k = 0; k < 8; ++k) s2 += (float)v[k] * (float)v[k]; }
                const float wv = WIDX[(size_t)(tok0 + q) * 8 + h];
                ((LAS float*)(lds + L_QN))[tid] = sqrtf(s2) * fabsf(wv); ((LAS float*)(lds + L_WQ))[tid] = wv; }
            __syncthreads();
            if (tid < 32) { const float kmax = sqrtf(__uint_as_float(__hip_atomic_load(kmaxp + b, __ATOMIC_RELAXED, __HIP_MEMORY_SCOPE_AGENT))); float bp = 0.f, bn = 0.f;
#pragma unroll
                for (int h = 0; h < 8; ++h) { const float t = ((const LAS float*)(lds + L_QN))[tid * 8 + h] * kmax; if (((const LAS float*)(lds + L_WQ))[tid * 8 + h] > 0.f) bp += t; else bn += t; }
                ((LAS float*)(lds + L_META))[tid] = bp > 0.f ? 1.0f / (bp * 1.0005f) : 0.f; ((LAS float*)(lds + L_META + 128))[tid] = bn > 0.f ? 1.0f / (bn * 1.0005f) : 0.f; }
#pragma unroll
            for (int e = 0; e < 8; ++e) ((LAS u32x4*)(lds + L_HIST))[tid + e * NTHREADS] = (u32x4){0u, 0u, 0u, 0u};
            if (tid < 64) ((LAS unsigned*)(lds + L_META + 512))[tid] = 0u;
            if (tid == 0) misc[1] = 0;
            __syncthreads();
            const h16* kb = KIDX + (size_t)b * SEQ * IDXD; const int npair = N >> 5;
            float* scache = (float*)(ws + scache_off((int)blockIdx.x));
            index_pass(lds, kb, N >> 6, wid, lane, scache);
            __syncthreads();
#if REP_PHASE == 32
            for (int e = 0; e < 8; ++e) ((LAS u32x4*)(lds + L_HIST))[tid + e * NTHREADS] = (u32x4){0u, 0u, 0u, 0u};
            __syncthreads();
            index_pass(lds, kb, N >> 6, wid, lane, scache);
            __syncthreads();
#endif
            int l2 = lane; asm volatile("" : "+v"(l2));
#pragma unroll 1
            for (int i = 0; i < 4; ++i) { const int q = wid * 4 + i; int tbin; unsigned nab, nin;
                find_thr(lds, q, (unsigned)TOPK, l2, tbin, nab, nin);
                unsigned tl = (unsigned)tbin << 10, th = ((unsigned)tbin + 1u) << 10;
                if (nin > (unsigned)CC) {
                    ((LAS u32x4*)(lds + L_HIST + q * 2048))[l2 * 2] = (u32x4){0u, 0u, 0u, 0u}; ((LAS u32x4*)(lds + L_HIST + q * 2048))[l2 * 2 + 1] = (u32x4){0u, 0u, 0u, 0u};
                    scan_q<2>(lds, scache, N, q, l2, (unsigned)tbin, 0.f, 0.f, ((const LAS float*)(lds + L_META))[q], ((const LAS float*)(lds + L_META + 128))[q]);
                    int tsub; unsigned nab2, nin2; find_thr(lds, q, (unsigned)TOPK - nab, l2, tsub, nab2, nin2);
                    tl = ((unsigned)tbin << 10) | (unsigned)tsub; th = tl + 1u; nab += nab2; }
                if (l2 == 0) { ((LAS unsigned*)(lds + L_META + 256))[q] = tl; ((LAS unsigned*)(lds + L_META + 768))[q] = th; ((LAS int*)(lds + L_META + 384))[q] = (int)nab; } }
            if (l2 < 8) { const int q = wid * 4 + (l2 >> 1); const unsigned T = ((const LAS unsigned*)(lds + L_META + ((l2 & 1) ? 768 : 256)))[q];
                ((LAS float*)(lds + L_QN + ((l2 & 1) ? 128 : 0)))[q] = thr_to_float(T, ((const LAS float*)(lds + L_META))[q], ((const LAS float*)(lds + L_META + 128))[q]); }
#pragma unroll 1
            for (int i = 0; i < 4; ++i) { const int q = wid * 4 + i;
                scan_q<3>(lds, scache, N, q, l2, 0u, ((const LAS float*)(lds + L_QN))[q], ((const LAS float*)(lds + L_QN + 128))[q], 0.f, 0.f);
                const unsigned mc = ((const LAS unsigned*)(lds + L_META + 640))[q]; const int m = mc < (unsigned)CC ? (int)mc : CC;
                const int nabq = ((const LAS int*)(lds + L_META + 384))[q], need = TOPK - nabq;
                const LAS u32x2* cd = (const LAS u32x2*)(lds + L_CAND) + q * CC;
                for (int c = l2; c < m; c += 64) { const u32x2 me = cd[c]; const float sc = __uint_as_float(me[0]); int rank = 0;
                    for (int k = 0; k < m; ++k) { const u32x2 ot = cd[k]; const float so = __uint_as_float(ot[0]); rank += (so > sc || (so == sc && ot[1] < me[1])) ? 1 : 0; }
                    if (rank < need) ((LAS unsigned short*)(lds + L_SEL))[q * 256 + nabq + rank] = (unsigned short)me[1]; } }
        }
        }
        __syncthreads();
        const int cnt = N < TOPK ? N : TOPK;
        for (int rep_ = 0; rep_ < REPATT; ++rep_)
        for (int i = 0; i < 4; ++i) { const int qi = wid * 4 + i; attn_query<0>(lds, QA + (size_t)(tok0 + qi) * (NH * KVD), KV + (size_t)b * SEQ * KVD, qi, cnt, wid, lane); }
        __syncthreads();
        {
            int lane2 = lane; asm volatile("" : "+v"(lane2));
            const int r = lane2 & 31, hh = lane2 >> 5;
            f32x16 acc0, acc1;
#pragma unroll
            for (int i = 0; i < 16; ++i) { acc0[i] = 0.f; acc1[i] = 0.f; }
            const h16* wu = WuvT + (size_t)(wid * 64 + r) * 128 + 8 * hh;
            const LAS unsigned char* ap = lds + L_OLAT + r * OL_STRIDE + wid * 256 + 16 * hh;
#pragma unroll
            for (int ks = 0; ks < 8; ++ks) { const h16x8 af = *(const LAS h16x8*)(ap + 32 * ks); const h16x8 b0 = *(const h16x8*)(wu + 16 * ks), b1 = *(const h16x8*)(wu + 32 * 128 + 16 * ks);
                acc0 = __builtin_amdgcn_mfma_f32_32x32x16_f16(af, b0, acc0, 0, 0, 0); acc1 = __builtin_amdgcn_mfma_f32_32x32x16_f16(af, b1, acc1, 0, 0, 0); }
            LAS unsigned char* ob = lds + L_VBUF + (wid * 64 + r) * 2;
#pragma unroll
            for (int i = 0; i < 16; ++i) { const int q = (i & 3) + 8 * (i >> 2) + 4 * hh;
                *(LAS h16*)(ob + q * 1040) = (h16)acc0[i]; *(LAS h16*)(ob + q * 1040 + 64) = (h16)acc1[i]; }
        }
        __syncthreads();
        {
            int t2 = tid; asm volatile("" : "+v"(t2));
            const int q = t2 >> 4, c0 = (t2 & 15) * 32; const size_t tok = (size_t)(tok0 + q);
#pragma unroll
            for (int e = 0; e < 4; ++e) { const h16x8 ov = *(const LAS h16x8*)(lds + L_VBUF + q * 1040 + (c0 + 8 * e) * 2); const h16x8 zv = *(const h16x8*)(ZB + tok * GW + c0 + 8 * e); h16x8 o;
#pragma unroll
                for (int k = 0; k < 8; ++k) o[k] = (h16)((float)ov[k] * pg8::silu_f((float)zv[k]));
                *(h16x8*)(A2 + tok * DM + 512 + c0 + 8 * e) = o; }
        }
        __syncthreads();
    }
}
}


__device__ __forceinline__ void final_phase(const Args& a, const int g_wid) {
    int tid_ = TID(); asm volatile("" : "+v"(tid_));
    const h16* Y = (const h16*)(a.ws + WS_Y); const float* ssy = (const float*)(a.ws + WS_SSY);
    const size_t n4 = (size_t)T * DM / 4;
    for (size_t i = (size_t)blockIdx.x * blockDim.x + tid_; i < n4; i += (size_t)gridDim.x * blockDim.x) {
        const int row = (int)(i >> 8), c4 = (int)(i & 255);
        const float rstd = rsqrtf(ssy[row] * (1.f / DM) + EPS);
        const f32x4 xv = *((const f32x4*)a.x + i); const f32x4 g = *((const f32x4*)a.post_g + c4); const h16x4 yv = *((const h16x4*)Y + i);
        f32x4 o; o.x = xv.x + (float)yv.x * rstd * g.x; o.y = xv.y + (float)yv.y * rstd * g.y; o.z = xv.z + (float)yv.z * rstd * g.z; o.w = xv.w + (float)yv.w * rstd * g.w;
        *((f32x4*)a.out + i) = o;
    }
}


namespace gm {
constexpr int L_VN = 0;
constexpr int L_ST = 32768;
__device__ __forceinline__ int swz(int row) { return 2 * ((row & 3) | (((row >> 3) & 1) << 2)); }
__device__ __forceinline__ void phase(LAS unsigned char* lds, const Args& a, const int g_wid) {
    unsigned char* ws = a.ws;
    const h16* U = (const h16*)(ws + WS_U); const h16* V = (const h16*)(ws + WS_V); const h16* ZA = (const h16*)(ws + WS_ZA);
    const h16* WsH = (const h16*)(ws + WS_WSH); h16* A2 = (h16*)(ws + WS_A2);
    int tid = TID(); asm volatile("" : "+v"(tid));
    const int wid = __builtin_amdgcn_readfirstlane(tid >> 6), lane = tid & 63;
    for (int nb = blockIdx.x; nb < T / 128; nb += gridDim.x) {
        const int tok0 = nb * 128;
        {
            const int row = tid >> 2, part = tid & 3; const h16* vr = V + (size_t)(tok0 + row) * GW + part * 128; float s = 0.f, q = 0.f;
#pragma unroll 4
            for (int e = 0; e < 16; ++e) { const h16x8 v = *(const h16x8*)(vr + 8 * e);
#pragma unroll
                for (int k = 0; k < 8; k += 2) { const pg8::f32x2 gv = pg8::gelu_pk((pg8::f32x2){(float)v[k], (float)v[k + 1]}); s += gv.x + gv.y; q += gv.x * gv.x + gv.y * gv.y; } }
            s += __shfl_xor(s, 1); s += __shfl_xor(s, 2); q += __shfl_xor(q, 1); q += __shfl_xor(q, 2);
            const float m = s * (1.f / GW), var = fmaxf(q * (1.f / GW) - m * m, 0.f);
            if (part == 0) { ((LAS float*)(lds + L_ST))[row] = m; ((LAS float*)(lds + L_ST))[128 + row] = rsqrtf(var + EPS); } }
        __syncthreads();
        for (int g = 0; g < 4; ++g) {
            {
                const int row = tid >> 2, part = tid & 3; const float m = ((const LAS float*)(lds + L_ST))[row], rs = ((const LAS float*)(lds + L_ST))[128 + row];
                const h16* vr = V + (size_t)(tok0 + row) * GW + g * 128 + part * 32; const float* lg = a.ln_g + g * 128 + part * 32; const float* lb = a.ln_b + g * 128 + part * 32;
                const int sw = swz(row);
#pragma unroll
                for (int e = 0; e < 4; ++e) { const h16x8 v = *(const h16x8*)(vr + 8 * e); h16x8 o;
#pragma unroll
                    for (int k = 0; k < 8; k += 2) { const pg8::f32x2 gv = pg8::gelu_pk((pg8::f32x2){(float)v[k], (float)v[k + 1]});
                        o[k] = (h16)((gv.x - m) * rs * lg[8 * e + k] + lb[8 * e + k]); o[k + 1] = (h16)((gv.y - m) * rs * lg[8 * e + k + 1] + lb[8 * e + k + 1]); }
                    *(LAS h16x8*)(lds + L_VN + row * 256 + (((part * 4 + e) ^ sw) << 4)) = o; } }
            __syncthreads();
            {
                const int c15 = lane & 15, gq = lane >> 4, qq = c15 >> 2, pp = c15 & 3;
                const h16* wp = WsH + (size_t)(g * 128 + wid * 16 + c15) * 128 + 8 * gq;
                h16x8 wf[4];
#pragma unroll
                for (int ks = 0; ks < 4; ++ks) wf[ks] = *(const h16x8*)(wp + 32 * ks);
                f32x4 acc[8];
#pragma unroll
                for (int ct = 0; ct < 8; ++ct) acc[ct] = (f32x4){0.f, 0.f, 0.f, 0.f};
#pragma unroll
                for (int ks = 0; ks < 4; ++ks) {
                    const int r0 = 32 * ks + 8 * gq + qq, r1 = r0 + 4;
                    const unsigned b0 = (unsigned)(uintptr_t)(lds + L_VN + r0 * 256 + 16 * (pp >> 1) + 8 * (pp & 1)), b1 = (unsigned)(uintptr_t)(lds + L_VN + r1 * 256 + 16 * (pp >> 1) + 8 * (pp & 1));
                    const int s0 = swz(r0) >> 1, s1 = swz(r1) >> 1;
                    p3::s16x4 lo[8], hi[8];
#pragma unroll
                    for (int ct = 0; ct < 8; ++ct) { const unsigned a0 = b0 + (unsigned)((ct ^ s0) << 5), a1 = b1 + (unsigned)((ct ^ s1) << 5);
                        asm volatile("ds_read_b64_tr_b16 %0, %1" : "=&v"(lo[ct]) : "v"(a0) : "memory");
                        asm volatile("ds_read_b64_tr_b16 %0, %1" : "=&v"(hi[ct]) : "v"(a1) : "memory"); }
                    asm volatile("s_waitcnt lgkmcnt(0)" ::: "memory"); __builtin_amdgcn_sched_barrier(0);
#pragma unroll
                    for (int ct = 0; ct < 8; ++ct) { typedef short s16x8 __attribute__((ext_vector_type(8)));
                        const s16x8 va = (s16x8){lo[ct][0], lo[ct][1], lo[ct][2], lo[ct][3], hi[ct][0], hi[ct][1], hi[ct][2], hi[ct][3]};
                        acc[ct] = __builtin_amdgcn_mfma_f32_16x16x32_f16(__builtin_bit_cast(h16x8, va), wf[ks], acc[ct], 0, 0, 0); }
                }
                const int tl = wid * 16 + c15; const float bs = a.b_s[g * 128 + tl]; const size_t tok = (size_t)(tok0 + tl);
#pragma unroll
                for (int ct = 0; ct < 8; ++ct) { const int ch = g * 128 + 16 * ct + 4 * gq;
                    const h16x4 uu = *(const h16x4*)(U + tok * GW + ch), zz = *(const h16x4*)(ZA + tok * GW + ch); h16x4 o;
#pragma unroll
                    for (int e = 0; e < 4; e += 2) { const pg8::f32x2 gu = pg8::gelu_pk((pg8::f32x2){(float)uu[e], (float)uu[e + 1]});
                        o[e] = (h16)(gu.x * (acc[ct][e] + bs) * pg8::silu_f((float)zz[e])); o[e + 1] = (h16)(gu.y * (acc[ct][e + 1] + bs) * pg8::silu_f((float)zz[e + 1])); }
                    *(h16x4*)(A2 + tok * DM + ch) = o; }
            }
            __syncthreads();
        }
    }
}
}

#define XB_TMO      128
#define XB_XCNT(j)  (256  + 64 * (j))
#define XB_XSUB(j)  (1280 + 64 * (j))
#define XB_XGEN(j)  (2304 + 64 * (j))
#define XB_TOP      3328
#define XB_TOPGEN   3392
#define XCD_BAR_WORDS 3456
#define XB_SPIN_CAP (1u << 18)
__device__ __forceinline__ unsigned xb_ld(unsigned* p)              { return __hip_atomic_load(p, __ATOMIC_RELAXED, __HIP_MEMORY_SCOPE_AGENT); }
__device__ __forceinline__ unsigned xb_add(unsigned* p, unsigned v) { return __hip_atomic_fetch_add(p, v, __ATOMIC_RELAXED, __HIP_MEMORY_SCOPE_AGENT); }
__device__ __forceinline__ unsigned xb_xcc_id() { return (unsigned)__builtin_amdgcn_s_getreg((3 << 11) | 20) & 0xFu; }
#define XB_SPIN(cond, bar) do { unsigned _sp = 0; while (cond) { __builtin_amdgcn_s_sleep(1); \
    if ((++_sp & 255u) == 0u) { if (xb_ld(&(bar)[XB_TMO])) break; if (_sp > XB_SPIN_CAP) { atomicAdd(&(bar)[XB_TMO], 1u); break; } } } } while (0)
struct XcdBarrier { unsigned* bar; unsigned x; volatile LAS unsigned* st; };
__device__ __forceinline__ XcdBarrier xcd_barrier_post(unsigned* bar, volatile LAS unsigned* st, const int g_wid) {
    XcdBarrier b; b.bar = bar; b.x = xb_xcc_id(); b.st = st;
    if (TID() == 0) (void)xb_add(&bar[XB_XCNT(b.x)], 1u);
    return b;
}
__device__ __forceinline__ void xcd_barrier_complete(unsigned* bar, unsigned x, unsigned& nloc, unsigned& nx) {
    const unsigned G = gridDim.x * gridDim.y * gridDim.z;
    unsigned sum, cnt, mine, sp = 0u;
    for (;;) {
        sum = 0u; cnt = 0u; mine = 0u;
#pragma unroll
        for (unsigned j = 0; j < 16; ++j) { const unsigned c = xb_ld(&bar[XB_XCNT(j)]); sum += c; cnt += (c > 0u) ? 1u : 0u; mine = (j == x) ? c : mine; }
        if (sum == G) break;
        __builtin_amdgcn_s_sleep(1);
        if ((++sp & 255u) == 0u) { if (xb_ld(&bar[XB_TMO])) break; if (sp > XB_SPIN_CAP) { atomicAdd(&bar[XB_TMO], 1u); break; } }
    }
    nloc = mine > 0u ? mine : 1u; nx = cnt > 0u ? cnt : 1u;
}
__device__ __forceinline__ void xcd_barrier(const XcdBarrier& b, const int g_wid) {
    asm volatile("s_waitcnt vmcnt(0)" ::: "memory");
    __syncthreads();
    if (TID() == 0) {
        unsigned* bar = b.bar;
        __builtin_amdgcn_s_waitcnt(0);
        unsigned nloc = b.st[0], nx = b.st[1];
        if (nloc == 0u) { xcd_barrier_complete(bar, b.x, nloc, nx); b.st[0] = nloc; b.st[1] = nx; }
        const unsigned old = xb_add(&bar[XB_XSUB(b.x)], 1u);
        const unsigned gen = old / nloc;
        if (old + 1u == (gen + 1u) * nloc) {
            __builtin_amdgcn_fence(__ATOMIC_RELEASE, "agent");
            asm volatile("s_waitcnt vmcnt(0)" ::: "memory");
            const unsigned og = xb_add(&bar[XB_TOP], 1u);
            const unsigned tg = og / nx;
            if (og + 1u == (tg + 1u) * nx) xb_add(&bar[XB_TOPGEN], 1u);
            else XB_SPIN(xb_ld(&bar[XB_TOPGEN]) == tg, bar);
            __builtin_amdgcn_fence(__ATOMIC_ACQUIRE, "agent");
            xb_add(&bar[XB_XGEN(b.x)], 1u);
            asm volatile("s_waitcnt vmcnt(0)" ::: "memory");
        } else {
            XB_SPIN(xb_ld(&bar[XB_XGEN(b.x)]) == gen, bar);
            __builtin_amdgcn_fence(__ATOMIC_ACQUIRE, "agent");
            asm volatile("s_waitcnt vmcnt(0)" ::: "memory");
        }
    }
    __syncthreads();
}

#ifndef MK_PER_PHASE
#define MK_PER_PHASE 0
#endif
constexpr int LDS_TOTAL = 153600;
constexpr int L_BARST = LDS_TOTAL - 64;
constexpr size_t WS_BAR = 16384;
static_assert(p3::L_END <= L_BARST && pg8::STAGE_BYTES <= L_BARST && WS_BAR + XCD_BAR_WORDS * 4 <= WS_SSQ, "maps");

struct MArgs { Args a; int ph_lo, ph_hi; };
__global__ __launch_bounds__(NTHREADS, 2) void mega(MArgs m) {
    extern __shared__ __attribute__((aligned(16))) unsigned char lds_raw[];
    LAS unsigned char* lds = (LAS unsigned char*)lds_raw;
    const Args& a = m.a; unsigned char* ws = a.ws;
    volatile LAS unsigned* st = (volatile LAS unsigned*)(lds + L_BARST);
    const int g_wid = 0;
    if (threadIdx.x < 16) st[threadIdx.x] = 0u;
    __syncthreads();
    XcdBarrier bar; bar.bar = (unsigned*)(ws + WS_BAR); bar.x = 0; bar.st = st;
    if (!MK_PER_PHASE) bar = xcd_barrier_post((unsigned*)(ws + WS_BAR), st, g_wid);
#define IN(k) (m.ph_lo <= (k) && (k) < m.ph_hi)
#define SEAM(k) do { if (IN(k) && IN((k) + 1)) xcd_barrier(bar, g_wid); } while (0)
    constexpr size_t WS_DUMMY = 443 * MiB;
#define REPS(k) ((REP_PHASE == (k)) ? 2 : 1)
    for (int rp = 0; rp < REPS(0); ++rp) { if (rp) xcd_barrier(bar, g_wid);
    if (IN(0)) { prep_weights(a, g_wid, lds); prep_x(a, g_wid); } }
    SEAM(0);
    for (int rp = 0; rp < REPS(1); ++rp) { if (rp) xcd_barrier(bar, g_wid);
    if (IN(1)) {
        pg8::Gemm g{(const h16*)(ws + WS_X16), (const h16*)(ws + WS_WINT), T, NP, DM};
        pg8::StaticOrder S; S.init(T, NP, gridDim.x, blockIdx.x);
        pg8::EpiProj E{(h16*)(ws + WS_U), (h16*)(ws + WS_V), (h16*)(ws + WS_ZA), (h16*)(ws + WS_ZB), (h16*)(ws + WS_CQ), (h16*)(ws + WS_KV), (h16*)(ws + WS_KIDX),
                       (float*)(ws + WS_CKVR), (float*)(ws + WS_WIDX), (float*)(ws + (rp ? WS_DUMMY : WS_SSQ)), (float*)(ws + (rp ? WS_DUMMY + T * 4 : WS_SSKV)), (const float*)(ws + WS_ROPE)};
        pg8::gemm_phase<pg8::EpiProj, true>(lds, g, S, E, g_wid);
    } }
    SEAM(1);
    if (IN(2)) {
        for (int rp = 0; rp < REPS(20); ++rp)
        { pg8::Gemm g{(const h16*)(ws + WS_CQ), (const h16*)(ws + WS_W2T), T, N2, QR};
          pg8::StaticOrder S; S.init(T, N2, gridDim.x, blockIdx.x);
          pg8::EpiQ E{(h16*)(ws + WS_QA), (h16*)(ws + WS_QIDX), (const float*)(ws + WS_SSQ), (const float*)(ws + WS_ROPE)};
          pg8::gemm_phase<pg8::EpiQ, true>(lds, g, S, E, g_wid); }
        for (int rp = 0; rp < REPS(21); ++rp) gm::phase(lds, a, g_wid);
        for (int rp = 0; rp < REPS(22); ++rp) ckvnorm_phase(a, g_wid);
    }
    SEAM(2);
    for (int rp = 0; rp < REPS(3); ++rp) { if (rp) xcd_barrier(bar, g_wid);
    if (IN(3)) p3::phase<REPS(30), REPS(31)>(lds, ws, rp ? 2048 : 0, g_wid); }
    SEAM(3);
    for (int rp = 0; rp < REPS(4); ++rp) { if (rp) xcd_barrier(bar, g_wid);
    if (IN(4)) {
        pg8::Gemm g{(const h16*)(ws + WS_A2), (const h16*)(ws + WS_WOUTT), T, DM, DM};
        pg8::StaticOrder S; S.init(T, DM, gridDim.x, blockIdx.x);
        pg8::EpiOut E{(h16*)(ws + WS_Y), (float*)(ws + (rp ? WS_DUMMY : WS_SSY))};
        pg8::gemm_phase<pg8::EpiOut, true>(lds, g, S, E, g_wid);
    } }
    SEAM(4);
    for (int rp = 0; rp < REPS(5); ++rp) { if (rp) xcd_barrier(bar, g_wid);
    if (IN(5)) final_phase(a, g_wid); }
#undef IN
#undef SEAM
}

extern "C" void kernel_launch(void* const* d_in, const int* in_sizes, int n_in, void* d_out, int out_size, void* d_ws, size_t ws_size, hipStream_t stream) {
    static int grid = 0;
    if (grid == 0) {
        if (n_in != 15 || ws_size < WS_END) { fprintf(stderr, "kernel_launch: unexpected n_in %d / ws %zu\n", n_in, ws_size); grid = -1; return; }
        int dev = 0, cus = 0;
        if (hipGetDevice(&dev) != hipSuccess || hipDeviceGetAttribute(&cus, hipDeviceAttributeMultiprocessorCount, dev) != hipSuccess) { grid = -1; return; }
        if (hipFuncSetAttribute((const void*)mega, hipFuncAttributeMaxDynamicSharedMemorySize, LDS_TOTAL) != hipSuccess) { fprintf(stderr, "kernel_launch: hipFuncSetAttribute failed\n"); grid = -1; return; }
        grid = cus < 256 ? cus : 256;
    }
    if (grid < 0) return;
    (void)hipMemsetAsync((char*)d_ws + WS_CTL, 0, 1 * MiB, stream);
    MArgs m{};
    Args& a = m.a;
    a.x = (const float*)d_in[0]; a.w_in = (const float*)d_in[1]; a.pre_g = (const float*)d_in[2]; a.post_g = (const float*)d_in[3];
    a.ln_g = (const float*)d_in[4]; a.ln_b = (const float*)d_in[5]; a.w_s = (const float*)d_in[6]; a.b_s = (const float*)d_in[7];
    a.qn_g = (const float*)d_in[8]; a.kvn_g = (const float*)d_in[9]; a.w_uq = (const float*)d_in[10]; a.w_uk = (const float*)d_in[11];
    a.w_uv = (const float*)d_in[12]; a.w_qidx = (const float*)d_in[13]; a.w_out = (const float*)d_in[14];
    a.out = (float*)d_out; a.ws = (unsigned char*)d_ws;
#if MK_PER_PHASE
    for (int p = 0; p < 6; ++p) { m.ph_lo = p; m.ph_hi = p + 1; hipLaunchKernelGGL(mega, dim3(grid), dim3(NTHREADS), LDS_TOTAL, stream, m); }
#else
    m.ph_lo = 0; m.ph_hi = 6;
    hipLaunchKernelGGL(mega, dim3(grid), dim3(NTHREADS), LDS_TOTAL, stream, m);
#endif
}
```
